# Optimizing an MI355X kernel written in HIP

```python
import jax, jax.numpy as jnp
from jax import lax
import numpy as np

D_MODEL = 1024
BATCH = 1
SEQ = 16384
DEPTH = 2

GRID_W = 64
N_FOURIER_GROUPS = 4
FOURIER_GROUP_DIM = D_MODEL // 8
FOURIER_WIDTH = N_FOURIER_GROUPS * FOURIER_GROUP_DIM
CHUNK = 128
N_GATE_GROUPS = 4
GATE_GROUP_DIM = D_MODEL // 8
GATE_WIDTH = N_GATE_GROUPS * GATE_GROUP_DIM
AB_IN_WIDTH = FOURIER_WIDTH + 2 * GATE_WIDTH
AB_OUT_WIDTH = FOURIER_WIDTH + GATE_WIDTH
HEAD_DIM = 128
N_HEADS = D_MODEL // HEAD_DIM
N_KV_HEADS = 2
KV_GROUP = N_HEADS // N_KV_HEADS
QKV_WIDTH = (N_HEADS + 2 * N_KV_HEADS) * HEAD_DIM
Q_BLOCK = 128
ROPE_THETA = 10000.0
ROPE_FREQS_PER_AXIS = HEAD_DIM // 4
D_FF = ((8 * D_MODEL // 3 + 255) // 256) * 256
EPS = 1e-6
N_EVEN = (DEPTH + 1) // 2
N_ODD = DEPTH // 2

kernel_name = "hybrid_fourier_gmlp_axial_gqa_macaron_encoder"


def rmsnorm(x, g):
    xf = x.astype(jnp.float32)
    y = xf * lax.rsqrt(jnp.mean(xf * xf, axis=-1, keepdims=True) + EPS)
    return (y * g.astype(jnp.float32)).astype(x.dtype)


def swiglu(h, w_gate, w_up, w_down):
    return (jax.nn.silu(h @ w_gate) * (h @ w_up)) @ w_down


def fourier_gating_mixer(h, w_in, v_norm, w_s, b_s, w_out):
    B, S, _ = h.shape
    z = h @ w_in
    f = z[..., :FOURIER_WIDTH].reshape(B, S, N_FOURIER_GROUPS, FOURIER_GROUP_DIM)
    f = jnp.fft.fft2(f.astype(jnp.float32), axes=(1, 3), norm="ortho").real
    f = f.astype(h.dtype).reshape(B, S, FOURIER_WIDTH)
    uv = jax.nn.gelu(z[..., FOURIER_WIDTH:])
    u = uv[..., :GATE_WIDTH]
    v = rmsnorm(uv[..., GATE_WIDTH:].reshape(B, S, N_GATE_GROUPS, GATE_GROUP_DIM), v_norm)
    vc = v.reshape(B, S // CHUNK, CHUNK, N_GATE_GROUPS, GATE_GROUP_DIM)
    s = jnp.einsum('gpq,bcqgd->bcpgd', w_s, vc) + b_s.T[None, None, :, :, None]
    gated = u * s.reshape(B, S, GATE_WIDTH)
    return jnp.concatenate([f, gated], axis=-1) @ w_out


def axial_rope_tables(S):
    rows = S // GRID_W
    row_idx = jnp.broadcast_to(jnp.arange(rows)[:, None], (rows, GRID_W)).reshape(S)
    col_idx = jnp.broadcast_to(jnp.arange(GRID_W)[None, :], (rows, GRID_W)).reshape(S)
    inv_freq = ROPE_THETA ** (-jnp.arange(ROPE_FREQS_PER_AXIS, dtype=jnp.float32) / ROPE_FREQS_PER_AXIS)
    ang = jnp.concatenate([row_idx.astype(jnp.float32)[:, None] * inv_freq[None, :],
                           col_idx.astype(jnp.float32)[:, None] * inv_freq[None, :]], axis=-1)
    return jnp.cos(ang), jnp.sin(ang)


def apply_rope(x, cos, sin):
    B, S, H, D = x.shape
    xp = x.astype(jnp.float32).reshape(B, S, H, D // 2, 2)
    x0, x1 = xp[..., 0], xp[..., 1]
    c = cos[None, :, None, :]
    s = sin[None, :, None, :]
    y = jnp.stack([x0 * c - x1 * s, x0 * s + x1 * c], axis=-1)
    return y.reshape(B, S, H, D).astype(x.dtype)


def axial_gqa(h, w_qkv, q_norm, k_norm, w_o):
    B, S, _ = h.shape
    qkv = h @ w_qkv
    q = qkv[..., :N_HEADS * HEAD_DIM].reshape(B, S, N_HEADS, HEAD_DIM)
    k = qkv[..., N_HEADS * HEAD_DIM:(N_HEADS + N_KV_HEADS) * HEAD_DIM].reshape(B, S, N_KV_HEADS, HEAD_DIM)
    v = qkv[..., (N_HEADS + N_KV_HEADS) * HEAD_DIM:].reshape(B, S, N_KV_HEADS, HEAD_DIM)
    cos, sin = axial_rope_tables(S)
    q = apply_rope(rmsnorm(q, q_norm), cos, sin) * (HEAD_DIM ** -0.5)
    k = apply_rope(rmsnorm(k, k_norm), cos, sin)
    nb = S // Q_BLOCK
    qb = q.reshape(B, nb, Q_BLOCK, N_KV_HEADS, KV_GROUP, HEAD_DIM).transpose(1, 0, 2, 3, 4, 5)

    def block(q_blk):
        sc = jnp.einsum('bqkgd,bskd->bkgqs', q_blk, k, preferred_element_type=jnp.float32)
        p = jax.nn.softmax(sc, axis=-1)
        return jnp.einsum('bkgqs,bskd->bqkgd', p.astype(v.dtype), v)

    o = lax.map(block, qb)
    o = o.transpose(1, 0, 2, 3, 4, 5).reshape(B, S, N_HEADS * HEAD_DIM)
    return o @ w_o


def setup_inputs(seed: int = 0) -> dict:
    key = jax.random.key(seed)
    ks = jax.random.split(key, 24)
    f32 = jnp.float32

    def w(k, shape, fan_in):
        return jax.random.normal(k, shape, f32) * (fan_in ** -0.5)

    def gain(k, shape):
        return 1.0 + 0.02 * jax.random.normal(k, shape, f32)

    return {
        "x": jax.random.normal(ks[0], (BATCH, SEQ, D_MODEL), f32),
        "ffn1_norm": gain(ks[1], (DEPTH, D_MODEL)),
        "ffn1_w_gate": w(ks[2], (DEPTH, D_MODEL, D_FF), D_MODEL),
        "ffn1_w_up": w(ks[3], (DEPTH, D_MODEL, D_FF), D_MODEL),
        "ffn1_w_down": w(ks[4], (DEPTH, D_FF, D_MODEL), D_FF),
        "mix_norm": gain(ks[5], (DEPTH, D_MODEL)),
        "ab_w_in": w(ks[6], (N_EVEN, D_MODEL, AB_IN_WIDTH), D_MODEL),
        "ab_v_norm": gain(ks[7], (N_EVEN, N_GATE_GROUPS, GATE_GROUP_DIM)),
        "ab_w_s": w(ks[8], (N_EVEN, N_GATE_GROUPS, CHUNK, CHUNK), CHUNK),
        "ab_b_s": gain(ks[9], (N_EVEN, N_GATE_GROUPS, CHUNK)),
        "ab_w_out": w(ks[10], (N_EVEN, AB_OUT_WIDTH, D_MODEL), AB_OUT_WIDTH),
        "attn_w_qkv": w(ks[11], (N_ODD, D_MODEL, QKV_WIDTH), D_MODEL),
        "attn_q_norm": gain(ks[12], (N_ODD, HEAD_DIM)),
        "attn_k_norm": gain(ks[13], (N_ODD, HEAD_DIM)),
        "attn_w_o": w(ks[14], (N_ODD, N_HEADS * HEAD_DIM, D_MODEL), N_HEADS * HEAD_DIM),
        "ffn2_norm": gain(ks[15], (DEPTH, D_MODEL)),
        "ffn2_w_gate": w(ks[16], (DEPTH, D_MODEL, D_FF), D_MODEL),
        "ffn2_w_up": w(ks[17], (DEPTH, D_MODEL, D_FF), D_MODEL),
        "ffn2_w_down": w(ks[18], (DEPTH, D_FF, D_MODEL), D_FF),
        "final_norm": gain(ks[19], (D_MODEL,)),
    }


def reference(x, ffn1_norm, ffn1_w_gate, ffn1_w_up, ffn1_w_down, mix_norm,
              ab_w_in, ab_v_norm, ab_w_s, ab_b_s, ab_w_out,
              attn_w_qkv, attn_q_norm, attn_k_norm, attn_w_o,
              ffn2_norm, ffn2_w_gate, ffn2_w_up, ffn2_w_down, final_norm):
    for layer in range(DEPTH):
        x = x + 0.5 * swiglu(rmsnorm(x, ffn1_norm[layer]), ffn1_w_gate[layer],
                             ffn1_w_up[layer], ffn1_w_down[layer])
        h = rmsnorm(x, mix_norm[layer])
        i = layer // 2
        if layer % 2 == 0:
            x = x + fourier_gating_mixer(h, ab_w_in[i], ab_v_norm[i], ab_w_s[i],
                                         ab_b_s[i], ab_w_out[i])
        else:
            x = x + axial_gqa(h, attn_w_qkv[i], attn_q_norm[i], attn_k_norm[i], attn_w_o[i])
        x = x + 0.5 * swiglu(rmsnorm(x, ffn2_norm[layer]), ffn2_w_gate[layer],
                             ffn2_w_up[layer], ffn2_w_down[layer])
    return rmsnorm(x, final_norm)
```

```cpp
#include <hip/hip_runtime.h>
#include <hip/hip_bf16.h>
#include <cstdio>
#include <cstdint>
#include <cmath>
namespace nv {
constexpr int M = 16384, DM = 1024, FF = 2816, S = 16384;
constexpr float EPS = 1e-6f;

__global__ __launch_bounds__(256) void k_rmsnorm(const float* x, const float* __restrict__ g, float* y, int rows, int D) {
  const int wave = (blockIdx.x * 256 + threadIdx.x) >> 6, lane = threadIdx.x & 63, nw = gridDim.x * 4;
  for (int r = wave; r < rows; r += nw) {
    const float* xr = x + (size_t)r * D; float s = 0.f;
    for (int i = lane; i < D; i += 64) { float v = xr[i]; s += v * v; }
    for (int o = 32; o; o >>= 1) s += __shfl_xor(s, o);
    const float rs = rsqrtf(s / (float)D + EPS);
    for (int i = lane; i < D; i += 64) y[(size_t)r * D + i] = xr[i] * rs * g[i];
  }
}
__global__ __launch_bounds__(256) void k_headnorm_rope(float* __restrict__ buf, int ld, int col0, int nh, const float* __restrict__ g, float outscale) {
  const int wave = (blockIdx.x * 256 + threadIdx.x) >> 6, lane = threadIdx.x & 63, nw = gridDim.x * 4;
  for (int it = wave; it < M * nh; it += nw) {
    const int t = it / nh, h = it % nh; float* p = buf + (size_t)t * ld + col0 + h * 128;
    float x0 = p[2 * lane], x1 = p[2 * lane + 1]; float s = x0 * x0 + x1 * x1;
    for (int o = 32; o; o >>= 1) s += __shfl_xor(s, o);
    const float rs = rsqrtf(s / 128.f + EPS); x0 = x0 * rs * g[2 * lane]; x1 = x1 * rs * g[2 * lane + 1];
    const int i = lane, j = i & 31; const float pos = (i < 32) ? (float)(t / 64) : (float)(t % 64);
    const float inv = powf(10000.f, -(float)j / 32.f); const float ang = pos * inv; const float c = cosf(ang), sn = sinf(ang);
    p[2 * lane] = (x0 * c - x1 * sn) * outscale; p[2 * lane + 1] = (x0 * sn + x1 * c) * outscale;
  }
}
__global__ __launch_bounds__(256) void k_swiglu(const float* __restrict__ g, const float* __restrict__ u, float* __restrict__ a, size_t n) {
  for (size_t i = blockIdx.x * 256ull + threadIdx.x; i < n; i += gridDim.x * 256ull) { const float v = g[i]; a[i] = v / (1.f + expf(-v)) * u[i]; }
}
__device__ __forceinline__ float gelu_tanh(float a) { return 0.5f * a * (1.f + tanhf(0.7978845608028654f * (a + 0.044715f * a * a * a))); }
__global__ __launch_bounds__(256) void k_uv_prep(float* __restrict__ u, float* __restrict__ v, const float* __restrict__ vnorm) {
  const int wave = (blockIdx.x * 256 + threadIdx.x) >> 6, lane = threadIdx.x & 63, nw = gridDim.x * 4;
  for (int it = wave; it < M * 4; it += nw) {
    const int t = it >> 2, g = it & 3; float* up = u + (size_t)t * 512 + g * 128; float* vp = v + (size_t)t * 512 + g * 128;
    up[lane] = gelu_tanh(up[lane]); up[lane + 64] = gelu_tanh(up[lane + 64]);
    float a = gelu_tanh(vp[lane]), b = gelu_tanh(vp[lane + 64]); float s = a * a + b * b;
    for (int o = 32; o; o >>= 1) s += __shfl_xor(s, o);
    const float rs = rsqrtf(s / 128.f + EPS);
    vp[lane] = a * rs * vnorm[g * 128 + lane]; vp[lane + 64] = b * rs * vnorm[g * 128 + lane + 64];
  }
}
__global__ __launch_bounds__(256) void k_gate(float* __restrict__ u, const float* __restrict__ vn, const float* __restrict__ ws, const float* __restrict__ bs) {
  for (size_t i = blockIdx.x * 256ull + threadIdx.x; i < (size_t)M * 512; i += gridDim.x * 256ull) {
    const int n = (int)(i >> 9), col = (int)(i & 511), g = col >> 7, c = n >> 7, p = n & 127;
    const float* w = ws + ((size_t)g * 128 + p) * 128; const float* vv = vn + (size_t)c * 128 * 512 + col; float s = 0.f;
    for (int q = 0; q < 128; ++q) s += w[q] * vv[(size_t)q * 512];
    u[i] = u[i] * (s + bs[g * 128 + p]);
  }
}
__global__ void k_tables(float* __restrict__ cosS, float* __restrict__ sinS, float* __restrict__ Cd, float* __restrict__ Sd) {
  const int i = blockIdx.x * 256 + threadIdx.x;
  if (i < 16384) { float s, c; sincospif((float)i / 8192.f, &s, &c); cosS[i] = c; sinS[i] = s; }
  if (i < 128 * 128) { const int d = i >> 7, k = i & 127; const int m = (d * k) & 127; float s, c; sincospif((float)m / 64.f, &s, &c); Cd[i] = c; Sd[i] = s; }
}
template <int AMODE>
__global__ __launch_bounds__(256) void k_sgemm(const float* __restrict__ A, int lda, const float* __restrict__ B, int ldb, float* __restrict__ C, int ldc, int K, float alpha, float beta) {
  __shared__ float As[16][128 + 4]; __shared__ float Bs[16][128 + 4];
  const int tid = threadIdx.x, tx = tid & 15, ty = tid >> 4; const int m0 = blockIdx.y * 128, n0 = blockIdx.x * 128;
  float acc[8][8];
#pragma unroll
  for (int i = 0; i < 8; ++i)
#pragma unroll
    for (int j = 0; j < 8; ++j) acc[i][j] = 0.f;
  const int ar = tid >> 1, ak = (tid & 1) * 8, bk = tid >> 4, bn = (tid & 15) * 8;
  for (int k0 = 0; k0 < K; k0 += 16) {
    float av[8];
    if (AMODE == 0) { const float4 p = *(const float4*)(A + (size_t)(m0 + ar) * lda + k0 + ak), q = *(const float4*)(A + (size_t)(m0 + ar) * lda + k0 + ak + 4);
      av[0] = p.x; av[1] = p.y; av[2] = p.z; av[3] = p.w; av[4] = q.x; av[5] = q.y; av[6] = q.z; av[7] = q.w; }
    else {
#pragma unroll
      for (int j = 0; j < 8; ++j) av[j] = A[((m0 + ar) * (k0 + ak + j)) & 16383]; }
    const float4 b0 = *(const float4*)(B + (size_t)(k0 + bk) * ldb + n0 + bn), b1 = *(const float4*)(B + (size_t)(k0 + bk) * ldb + n0 + bn + 4);
    __syncthreads();
#pragma unroll
    for (int j = 0; j < 8; ++j) As[ak + j][ar] = av[j];
    *(float4*)&Bs[bk][bn] = b0; *(float4*)&Bs[bk][bn + 4] = b1;
    __syncthreads();
#pragma unroll
    for (int kk = 0; kk < 16; ++kk) {
      const float4 a0 = *(const float4*)&As[kk][ty * 4], a1 = *(const float4*)&As[kk][64 + ty * 4];
      const float4 c0 = *(const float4*)&Bs[kk][tx * 4], c1 = *(const float4*)&Bs[kk][64 + tx * 4];
      const float a[8] = {a0.x, a0.y, a0.z, a0.w, a1.x, a1.y, a1.z, a1.w}, b[8] = {c0.x, c0.y, c0.z, c0.w, c1.x, c1.y, c1.z, c1.w};
#pragma unroll
      for (int i = 0; i < 8; ++i)
#pragma unroll
        for (int j = 0; j < 8; ++j) acc[i][j] = fmaf(a[i], b[j], acc[i][j]);
    }
  }
#pragma unroll
  for (int i = 0; i < 8; ++i) { const int r = m0 + (i < 4 ? ty * 4 + i : 64 + ty * 4 + i - 4);
#pragma unroll
    for (int jh = 0; jh < 2; ++jh) { float* cp = C + (size_t)r * ldc + n0 + jh * 64 + tx * 4; float4 o;
      if (beta != 0.f) { const float4 old = *(const float4*)cp; o.x = beta * old.x + alpha * acc[i][jh * 4 + 0]; o.y = beta * old.y + alpha * acc[i][jh * 4 + 1]; o.z = beta * old.z + alpha * acc[i][jh * 4 + 2]; o.w = beta * old.w + alpha * acc[i][jh * 4 + 3]; }
      else { o.x = alpha * acc[i][jh * 4 + 0]; o.y = alpha * acc[i][jh * 4 + 1]; o.z = alpha * acc[i][jh * 4 + 2]; o.w = alpha * acc[i][jh * 4 + 3]; }
      *(float4*)cp = o; } }
}
inline void sgemm(hipStream_t st, const float* A, int lda, const float* B, int ldb, float* C, int ldc, int Mr, int N, int K, float alpha, float beta) {
  hipLaunchKernelGGL(k_sgemm<0>, dim3(N / 128, Mr / 128), dim3(256), 0, st, A, lda, B, ldb, C, ldc, K, alpha, beta);
}
constexpr int ATT_LDS = (128 * 64 + 128 * 64 + 64 * 128 + 64 * 64 + 64 + 64 + 64) * 4;
__global__ __launch_bounds__(256) void k_attn(const float* __restrict__ q, const float* __restrict__ k, const float* __restrict__ v, float* __restrict__ o) {
  extern __shared__ __attribute__((aligned(16))) float sm[];
  float* Qt = sm;
  float* Kt = Qt + 128 * 64;
  float* Vs = Kt + 128 * 64;
  float* Ps = Vs + 64 * 128;
  float* mrow = Ps + 64 * 64; float* lrow = mrow + 64; float* arow = lrow + 64;
  const int tid = threadIdx.x, ti = tid >> 4, tj = tid & 15; const int h = blockIdx.y, kvh = h >> 2, i0 = blockIdx.x * 64;
  for (int e = tid; e < 64 * 128; e += 256) { const int i = e >> 7, d = e & 127; Qt[d * 64 + i] = q[(size_t)(i0 + i) * 1024 + h * 128 + d]; }
  if (tid < 64) { mrow[tid] = -1e30f; lrow[tid] = 0.f; }
  float oacc[4][8];
#pragma unroll
  for (int r = 0; r < 4; ++r)
#pragma unroll
    for (int c = 0; c < 8; ++c) oacc[r][c] = 0.f;
  for (int j0 = 0; j0 < S; j0 += 64) {
    __syncthreads();
    for (int e = tid; e < 64 * 128; e += 256) { const int j = e >> 7, d = e & 127; const size_t gi = (size_t)(j0 + j) * 256 + kvh * 128 + d; Kt[d * 64 + j] = k[gi]; Vs[j * 128 + d] = v[gi]; }
    __syncthreads();
    float s[4][4];
#pragma unroll
    for (int r = 0; r < 4; ++r)
#pragma unroll
      for (int c = 0; c < 4; ++c) s[r][c] = 0.f;
    for (int d = 0; d < 128; ++d) { const float4 a = *(const float4*)&Qt[d * 64 + ti * 4], b = *(const float4*)&Kt[d * 64 + tj * 4];
      const float av[4] = {a.x, a.y, a.z, a.w}, bv[4] = {b.x, b.y, b.z, b.w};
#pragma unroll
      for (int r = 0; r < 4; ++r)
#pragma unroll
        for (int c = 0; c < 4; ++c) s[r][c] = fmaf(av[r], bv[c], s[r][c]); }
#pragma unroll
    for (int r = 0; r < 4; ++r)
#pragma unroll
      for (int c = 0; c < 4; ++c) Ps[(ti * 4 + r) * 64 + tj * 4 + c] = s[r][c];
    __syncthreads();
    if (tid < 64) { float* pr = Ps + tid * 64; float mx = mrow[tid]; const float mo = mx;
      for (int j = 0; j < 64; ++j) mx = fmaxf(mx, pr[j]);
      float sum = 0.f; for (int j = 0; j < 64; ++j) { const float p = expf(pr[j] - mx); pr[j] = p; sum += p; }
      const float al = expf(mo - mx); arow[tid] = al; lrow[tid] = lrow[tid] * al + sum; mrow[tid] = mx; }
    __syncthreads();
#pragma unroll
    for (int r = 0; r < 4; ++r) { const float al = arow[ti * 4 + r];
#pragma unroll
      for (int c = 0; c < 8; ++c) oacc[r][c] *= al; }
    for (int j = 0; j < 64; ++j) { const float4 v0 = *(const float4*)&Vs[j * 128 + tj * 8], v1 = *(const float4*)&Vs[j * 128 + tj * 8 + 4];
      const float vv[8] = {v0.x, v0.y, v0.z, v0.w, v1.x, v1.y, v1.z, v1.w};
#pragma unroll
      for (int r = 0; r < 4; ++r) { const float p = Ps[(ti * 4 + r) * 64 + j];
#pragma unroll
        for (int c = 0; c < 8; ++c) oacc[r][c] = fmaf(p, vv[c], oacc[r][c]); } }
  }
  __syncthreads();
#pragma unroll
  for (int r = 0; r < 4; ++r) { const float il = 1.f / lrow[ti * 4 + r];
#pragma unroll
    for (int c = 0; c < 8; ++c) o[(size_t)(i0 + ti * 4 + r) * 1024 + h * 128 + tj * 8 + c] = oacc[r][c] * il; }
}

inline void ffn(hipStream_t st, float* X, const float* gn, const float* wg, const float* wu, const float* wd, float* scr) {
  constexpr int RC = 2048; float* H = scr; float* G = H + (size_t)RC * DM; float* U = G + (size_t)RC * FF;
  for (int r0 = 0; r0 < M; r0 += RC) {
    hipLaunchKernelGGL(k_rmsnorm, dim3(512), dim3(256), 0, st, X + (size_t)r0 * DM, gn, H, RC, DM);
    sgemm(st, H, DM, wg, FF, G, FF, RC, FF, DM, 1.f, 0.f);
    sgemm(st, H, DM, wu, FF, U, FF, RC, FF, DM, 1.f, 0.f);
    hipLaunchKernelGGL(k_swiglu, dim3(2048), dim3(256), 0, st, G, U, G, (size_t)RC * FF);
    sgemm(st, G, FF, wd, DM, X + (size_t)r0 * DM, DM, RC, DM, FF, 0.5f, 1.f);
  }
}
inline void mix0(hipStream_t st, float* X, const float* gn, const float* w_in, const float* vnorm, const float* w_s, const float* b_s, const float* w_out, float* scr) {
  float* H = scr; float* ZF = H + (size_t)M * DM; float* ZU = ZF + (size_t)M * 512; float* ZV = ZU + (size_t)M * 512; float* XC = ZV + (size_t)M * 512; float* XS = XC + (size_t)M * 512;
  float* cosS = XS + (size_t)M * 512; float* sinS = cosS + 16384; float* Cd = sinS + 16384; float* Sd = Cd + 16384;
  hipLaunchKernelGGL(k_tables, dim3(64), dim3(256), 0, st, cosS, sinS, Cd, Sd);
  hipLaunchKernelGGL(k_rmsnorm, dim3(1024), dim3(256), 0, st, X, gn, H, M, DM);
  sgemm(st, H, DM, w_in, 1536, ZF, 512, M, 512, DM, 1.f, 0.f);
  sgemm(st, H, DM, w_in + 512, 1536, ZU, 512, M, 512, DM, 1.f, 0.f);
  sgemm(st, H, DM, w_in + 1024, 1536, ZV, 512, M, 512, DM, 1.f, 0.f);
  for (int g = 0; g < 4; ++g) { sgemm(st, ZF + g * 128, 512, Cd, 128, XC + g * 128, 512, M, 128, 128, 1.f, 0.f); sgemm(st, ZF + g * 128, 512, Sd, 128, XS + g * 128, 512, M, 128, 128, 1.f, 0.f); }
  const float sc = 1.f / sqrtf(16384.f * 128.f);
  hipLaunchKernelGGL(k_sgemm<1>, dim3(512 / 128, M / 128), dim3(256), 0, st, cosS, 0, XC, 512, ZF, 512, S, sc, 0.f);
  hipLaunchKernelGGL(k_sgemm<1>, dim3(512 / 128, M / 128), dim3(256), 0, st, sinS, 0, XS, 512, ZF, 512, S, -sc, 1.f);
  hipLaunchKernelGGL(k_uv_prep, dim3(2048), dim3(256), 0, st, ZU, ZV, vnorm);
  hipLaunchKernelGGL(k_gate, dim3(4096), dim3(256), 0, st, ZU, ZV, w_s, b_s);
  sgemm(st, ZF, 512, w_out, DM, X, DM, M, DM, 512, 1.f, 1.f);
  sgemm(st, ZU, 512, w_out + (size_t)512 * DM, DM, X, DM, M, DM, 512, 1.f, 1.f);
}
inline void mix1(hipStream_t st, float* X, const float* gn, const float* w_qkv, const float* qn, const float* kn, const float* w_o, float* scr) {
  float* H = scr; float* Q = H + (size_t)M * DM; float* Kb = Q + (size_t)M * DM; float* Vb = Kb + (size_t)M * 256;
  hipLaunchKernelGGL(k_rmsnorm, dim3(1024), dim3(256), 0, st, X, gn, H, M, DM);
  sgemm(st, H, DM, w_qkv, 1536, Q, DM, M, DM, DM, 1.f, 0.f);
  sgemm(st, H, DM, w_qkv + 1024, 1536, Kb, 256, M, 256, DM, 1.f, 0.f);
  sgemm(st, H, DM, w_qkv + 1280, 1536, Vb, 256, M, 256, DM, 1.f, 0.f);
  hipLaunchKernelGGL(k_headnorm_rope, dim3(2048), dim3(256), 0, st, Q, DM, 0, 8, qn, 0.08838834764831845f);
  hipLaunchKernelGGL(k_headnorm_rope, dim3(2048), dim3(256), 0, st, Kb, 256, 0, 2, kn, 1.f);
  hipLaunchKernelGGL(k_attn, dim3(M / 64, 8), dim3(256), ATT_LDS, st, Q, Kb, Vb, H);
  sgemm(st, H, DM, w_o, DM, X, DM, M, DM, DM, 1.f, 1.f);
}
inline void final_norm(hipStream_t st, float* X, const float* g) { hipLaunchKernelGGL(k_rmsnorm, dim3(1024), dim3(256), 0, st, X, g, X, M, DM); }
inline void setup() { static bool done = false; if (!done) { (void)hipFuncSetAttribute((const void*)k_attn, hipFuncAttributeMaxDynamicSharedMemorySize, ATT_LDS); done = true; } }
}
extern "C" void kernel_launch(void* const* d_in, const int* in_sizes, int n_in, void* d_out, int out_size, void* d_ws, size_t ws_size, hipStream_t stream) {
  nv::setup();
  const float* const* in = (const float* const*)d_in;
  float* X = (float*)d_out; float* scr = (float*)d_ws;
  (void)hipMemcpyAsync(X, in[0], (size_t)nv::M * nv::DM * 4, hipMemcpyDeviceToDevice, stream);
  const size_t WFF = (size_t)nv::DM * nv::FF;
  nv::ffn(stream, X, in[1], in[2], in[3], in[4], scr);
  nv::mix0(stream, X, in[5], in[6], in[7], in[8], in[9], in[10], scr);
  nv::ffn(stream, X, in[15], in[16], in[17], in[18], scr);
  nv::ffn(stream, X, in[1] + 1024, in[2] + WFF, in[3] + WFF, in[4] + WFF, scr);
  nv::mix1(stream, X, in[5] + 1024, in[11], in[12], in[13], in[14], scr);
  nv::ffn(stream, X, in[15] + 1024, in[16] + WFF, in[17] + WFF, in[18] + WFF, scr);
  nv::final_norm(stream, X, in[19]);
}
```

```cpp
#include <hip/hip_runtime.h>
#include <hip/hip_bf16.h>
#include <cstdio>
#include <cstdint>
#include <cmath>
#define MK_MODE 0
#define MK_OPT_MASK 0x7f
namespace pg8 {
#define PG8_LAS __attribute__((address_space(3)))
typedef unsigned short bf16_t;
typedef short bf16x8 __attribute__((ext_vector_type(8)));
typedef float f32x4 __attribute__((ext_vector_type(4)));
typedef unsigned u32x4 __attribute__((ext_vector_type(4)));
typedef unsigned u32x2 __attribute__((ext_vector_type(2)));
constexpr int BM = 256, BK = 64, HALF = 128, HTB = HALF * BK * 2  , STAGE_BYTES = 8 * HTB, NXCD = 8, WGM = 8;

__host__ __device__ __forceinline__ int lds_byte(int r, int c) { const int st = (r >> 4) * 2 + (c >> 5), rr = r & 15, cc = c & 31, ob = rr * 64 + cc * 2; return st * 1024 + (ob ^ (((ob >> 9) & 1) << 5)); }
__host__ __device__ __forceinline__ void stage_rc(int b, int& R, int& C) { const int st = b / 1024, sb = b % 1024, swz = sb ^ (((sb >> 9) & 1) << 5); R = (st >> 1) * 16 + swz / 64; C = (st & 1) * 32 + (swz % 64) / 2; }
__host__ __device__ __forceinline__ int perm32(int rho) { const int n = rho >> 4, i = rho & 15; return 8 * (i >> 2) + 4 * n + (i & 3); }

struct Unit { int pm, pn; };
struct Gemm { const bf16_t* A; const bf16_t* Bt; int M, N, K; };

struct StaticOrder {
    int nM, nN, nwg, G, c;
    __host__ __device__ void init(int M, int N, int G_, int c_) { nM = M / BM; nN = N / BM; nwg = nM * nN; G = G_; c = c_; }
    __host__ __device__ bool next(int i, Unit& u) const {
        const long L = (long)i * G + c; if (L >= nwg) return false;
        int wgid = (int)L; { const int q = nwg / NXCD, r = nwg % NXCD, xcd = wgid % NXCD, off = wgid / NXCD; wgid = (xcd < r ? xcd * (q + 1) : r * (q + 1) + (xcd - r) * q) + off; }
        const int nig = WGM * nN, gid = wgid / nig, fm = gid * WGM, gsz = (nM - fm) < WGM ? (nM - fm) : WGM;
        u.pm = fm + ((wgid % nig) % gsz); u.pn = (wgid % nig) / gsz; return true;
    }
    __device__ __forceinline__ void a_ready(const Unit&) const {}
    __device__ __forceinline__ void done(const Unit&) const {}
};

__device__ __forceinline__ unsigned cvt_pk_bf16(float lo, float hi) { unsigned r; asm volatile("v_cvt_pk_bf16_f32 %0, %1, %2" : "=v"(r) : "v"(lo), "v"(hi)); return r; }
constexpr float RMS_EPS = 1e-6f;
__device__ __forceinline__ float silu_f(float x) { return x * __builtin_amdgcn_rcpf(1.0f + __builtin_amdgcn_exp2f(-1.4426950408889634f * x)); }
__device__ __forceinline__ float gelu_f(float x) { const float t = x * (1.0f + 0.044715f * x * x); return x * __builtin_amdgcn_rcpf(1.0f + __builtin_amdgcn_exp2f(-2.302208198f * t)); }

struct EpiGU {
    static constexpr bool PERM = true, AFTER_DRAIN = false;
    bf16_t* act; int ldc; const float* rowss; float inv_d;
    __device__ __forceinline__ void operator()(const f32x4 (&acc)[2][2][4][2], const Unit& u, int wr, int wc, int fr, int fq) const {
        const int row0 = u.pm * BM + wr * 64 + fr, col0 = u.pn * HALF + wc * 32 + 8 * fq;
#pragma unroll
        for (int ai = 0; ai < 2; ++ai)
#pragma unroll
            for (int m = 0; m < 4; ++m) { const int row = row0 + ai * HALF + m * 16; const float r = __builtin_amdgcn_rsqf(rowss[row] * inv_d + RMS_EPS);
                float o[8];
#pragma unroll
                for (int n = 0; n < 2; ++n)
#pragma unroll
                    for (int e = 0; e < 4; ++e) o[4 * n + e] = silu_f(acc[ai][0][m][n][e] * r) * (acc[ai][1][m][n][e] * r);
                u32x4 w; w.x = cvt_pk_bf16(o[0], o[1]); w.y = cvt_pk_bf16(o[2], o[3]); w.z = cvt_pk_bf16(o[4], o[5]); w.w = cvt_pk_bf16(o[6], o[7]);
                *(u32x4*)(act + (size_t)row * ldc + col0) = w; asm volatile("" ::: "memory"); }
    }
};
struct EpiRes {
    static constexpr bool PERM = false, AFTER_DRAIN = false;
    const float* xin; float* xout; bf16_t* xb; float* ss_out; float alpha;
    __device__ __forceinline__ void operator()(const f32x4 (&acc)[2][2][4][2], const Unit& u, int wr, int wc, int fr, int fq) const {
        const int row0 = u.pm * BM + wr * 64 + fr, col0 = u.pn * BM + wc * 32 + 4 * fq;
#pragma unroll
        for (int ai = 0; ai < 2; ++ai)
#pragma unroll
            for (int m = 0; m < 4; ++m) { const int row = row0 + ai * HALF + m * 16; const size_t off = (size_t)row * 1024 + col0; float ss = 0.f;
                f32x4 old[2][2];
#pragma unroll
                for (int bj = 0; bj < 2; ++bj)
#pragma unroll
                    for (int n = 0; n < 2; ++n) old[bj][n] = *(const f32x4*)(xin + off + bj * HALF + n * 16);
#pragma unroll
                for (int bj = 0; bj < 2; ++bj)
#pragma unroll
                    for (int n = 0; n < 2; ++n) { const f32x4 v = old[bj][n] + acc[ai][bj][m][n] * alpha; *(f32x4*)(xout + off + bj * HALF + n * 16) = v;
                        u32x2 w; w.x = cvt_pk_bf16(v[0], v[1]); w.y = cvt_pk_bf16(v[2], v[3]); *(u32x2*)(xb + off + bj * HALF + n * 16) = w;
                        ss += (v[0] * v[0] + v[1] * v[1]) + (v[2] * v[2] + v[3] * v[3]); }
                ss += __shfl_xor(ss, 16); ss += __shfl_xor(ss, 32);
                if (fq == 0) atomicAdd(ss_out + row, ss);
                asm volatile("" ::: "memory"); }
    }
};
struct EpiRoute {
    static constexpr bool PERM = true, AFTER_DRAIN = false;
    bf16_t* d0; bf16_t* d1; size_t d12; int ld1; int act_from; const float* rowss; float inv_d;
    __device__ __forceinline__ void operator()(const f32x4 (&acc)[2][2][4][2], const Unit& u, int wr, int wc, int fr, int fq) const {
        const int row0 = u.pm * BM + wr * 64 + fr; const int pn = u.pn;
        bf16_t* base = pn < 4 ? d0 + pn * BM : d1 + (size_t)(pn - 4) * d12; const int ld = pn < 4 ? 1024 : ld1; const bool act = pn >= act_from;
        const int col0 = wc * 32 + 8 * fq;
#pragma unroll
        for (int ai = 0; ai < 2; ++ai)
#pragma unroll
            for (int m = 0; m < 4; ++m) { const int row = row0 + ai * HALF + m * 16; const float r = __builtin_amdgcn_rsqf(rowss[row] * inv_d + RMS_EPS);
                bf16_t* rowp = base + (size_t)row * ld + col0;
#pragma unroll
                for (int bj = 0; bj < 2; ++bj) { float o[8];
#pragma unroll
                    for (int n = 0; n < 2; ++n)
#pragma unroll
                        for (int e = 0; e < 4; ++e) o[4 * n + e] = acc[ai][bj][m][n][e] * r;
                    if (act) {
#pragma unroll
                        for (int e = 0; e < 8; ++e) o[e] = gelu_f(o[e]); }
                    u32x4 w; w.x = cvt_pk_bf16(o[0], o[1]); w.y = cvt_pk_bf16(o[2], o[3]); w.z = cvt_pk_bf16(o[4], o[5]); w.w = cvt_pk_bf16(o[6], o[7]);
                    *(u32x4*)(rowp + bj * HALF) = w; } asm volatile("" ::: "memory"); }
    }
};
template <class Epi, class Sched, bool ALIGN_EPI = false, bool SP2 = false>
__device__ __forceinline__ void gemm_phase(PG8_LAS unsigned char* lds, const Gemm g, const Sched& S, const Epi& E) {
    int tid_ = threadIdx.x; asm volatile("" : "+v"(tid_));
    const int tid = tid_, wid = __builtin_amdgcn_readfirstlane(tid >> 6), lane = tid & 63, wr = wid >> 2, wc = wid & 3, fr = lane & 15, fq = lane >> 4;
    const int K = g.K, nt = K / BK;
    unsigned voffA[2], voffB[2];
#pragma unroll
    for (int i = 0; i < 2; ++i) { int R, C; stage_rc(tid * 16 + i * 8192, R, C); const int Rb = Epi::PERM ? ((R & ~31) + perm32(R & 31)) : R;
        voffA[i] = (unsigned)(R * K + C) * 2u; voffB[i] = (unsigned)(Rb * K + C) * 2u; }
    const size_t kstep = (size_t)(BK * 2);
    const size_t hstep = (size_t)HALF * K * 2;
    const size_t tstep = 2 * hstep;
    const unsigned ldsw = (unsigned)wid * 1024u;
    const int aoff = lds_byte(wr * 64 + fr, fq * 8), boff = lds_byte(wc * 32 + fr, fq * 8);
#define PG8_SA(b, h) (((b) * 2 + (h)) * HTB)
#define PG8_SB(b, h) ((4 + (b) * 2 + (h)) * HTB)
#define PG8_STAGE(bufoff, gbase, voff) do { _Pragma("unroll") for (int _i = 0; _i < 2; ++_i) \
        __builtin_amdgcn_global_load_lds((const unsigned*)((const char*)(gbase) + (voff)[_i]), (PG8_LAS unsigned*)(lds + (bufoff) + ldsw + _i * 8192), 16, 0, 0); } while (0)
#define PG8_LDA(dst, b, h) do { _Pragma("unroll") for (int m = 0; m < 4; ++m) _Pragma("unroll") for (int k = 0; k < 2; ++k) dst[m][k] = *(const PG8_LAS bf16x8*)(lds + PG8_SA(b, h) + aoff + m * 2048 + k * 1024); } while (0)
#define PG8_LDB(dst, b, h) do { _Pragma("unroll") for (int n = 0; n < 2; ++n) _Pragma("unroll") for (int k = 0; k < 2; ++k) dst[n][k] = *(const PG8_LAS bf16x8*)(lds + PG8_SB(b, h) + boff + n * 2048 + k * 1024); } while (0)
#define PG8_MMA(ai, bj, At, Bt) do { __builtin_amdgcn_s_setprio(1); _Pragma("unroll") for (int m = 0; m < 4; ++m) _Pragma("unroll") for (int n = 0; n < 2; ++n) _Pragma("unroll") for (int k = 0; k < 2; ++k) \
        acc[ai][bj][m][n] = __builtin_amdgcn_mfma_f32_16x16x32_bf16(Bt[n][k], At[m][k], acc[ai][bj][m][n], 0, 0, 0); __builtin_amdgcn_s_setprio(0); } while (0)
#define PG8_WAIT_V(n) asm volatile("s_waitcnt vmcnt(" #n ")" ::: "memory")
#define PG8_WAIT_L(n) asm volatile("s_waitcnt lgkmcnt(" #n ")" ::: "memory")
#define PG8_BAR __builtin_amdgcn_s_barrier()
#define PG8_SCHED __builtin_amdgcn_sched_barrier(0)
    Unit cur, nxt; int ui = 0;
    if (!S.next(0, cur)) return;
    f32x4 acc[2][2][4][2];
#pragma unroll
    for (int a = 0; a < 2; ++a)
#pragma unroll
        for (int b = 0; b < 2; ++b)
#pragma unroll
            for (int m = 0; m < 4; ++m)
#pragma unroll
                for (int n = 0; n < 2; ++n) acc[a][b][m][n] = (f32x4){0.f, 0.f, 0.f, 0.f};
    bf16x8 At[4][2], B0[2][2], B1[2][2];
    const char* cA = (const char*)g.A + (size_t)cur.pm * tstep; const char* cB = (const char*)g.Bt + (size_t)cur.pn * tstep;
    S.a_ready(cur);
    if constexpr (SP2) {
        PG8_STAGE(PG8_SB(0, 0), cB, voffB); PG8_STAGE(PG8_SB(0, 1), cB + hstep, voffB); PG8_STAGE(PG8_SA(0, 0), cA, voffA); PG8_STAGE(PG8_SA(0, 1), cA + hstep, voffA);
        if (wr == 1) PG8_BAR;
        PG8_WAIT_V(2); PG8_BAR;
        PG8_STAGE(PG8_SB(1, 0), cB + kstep, voffB); PG8_STAGE(PG8_SA(1, 0), cA + kstep, voffA); PG8_STAGE(PG8_SB(1, 1), cB + hstep + kstep, voffB);
        PG8_WAIT_V(6); PG8_BAR;
    } else {
        PG8_STAGE(PG8_SB(0, 0), cB, voffB); PG8_STAGE(PG8_SA(0, 0), cA, voffA); PG8_STAGE(PG8_SB(0, 1), cB + hstep, voffB); PG8_STAGE(PG8_SA(0, 1), cA + hstep, voffA);
        if (wr == 1) PG8_BAR;
        PG8_WAIT_V(4); PG8_BAR;
        PG8_STAGE(PG8_SB(1, 0), cB + kstep, voffB); PG8_STAGE(PG8_SA(1, 0), cA + kstep, voffA); PG8_STAGE(PG8_SB(1, 1), cB + hstep + kstep, voffB);
        PG8_WAIT_V(6); PG8_BAR;
    }
    for (;;) {
        const bool has_next = S.next(ui + 1, nxt);
        const char* nA = has_next ? (const char*)g.A + (size_t)nxt.pm * tstep : cA; const char* nB = has_next ? (const char*)g.Bt + (size_t)nxt.pn * tstep : cB;
        for (int t = 0; t < nt; t += 2) {
            const bool last = (t == nt - 2);
            const char* a1 = cA + (size_t)(t + 1) * kstep;
            const char* a2 = last ? nA : cA + (size_t)(t + 2) * kstep; const char* b2 = last ? nB : cB + (size_t)(t + 2) * kstep;
            const char* a3 = a2 + kstep; const char* b3 = b2 + kstep;
            if (last && has_next) S.a_ready(nxt);
            if constexpr (SP2) {
            PG8_LDB(B0, 0, 0); PG8_LDB(B1, 0, 1); PG8_SCHED; PG8_LDA(At, 0, 0); PG8_STAGE(PG8_SA(1, 1), a1 + hstep, voffA);
            PG8_WAIT_V(8); PG8_WAIT_L(0); PG8_BAR; PG8_MMA(0, 0, At, B0); PG8_MMA(0, 1, At, B1); PG8_BAR; PG8_SCHED;
            PG8_LDA(At, 0, 1); PG8_STAGE(PG8_SB(0, 0), b2, voffB); PG8_STAGE(PG8_SB(0, 1), b2 + hstep, voffB); PG8_STAGE(PG8_SA(0, 0), a2, voffA);
            PG8_WAIT_V(8); PG8_WAIT_L(0); PG8_BAR; PG8_MMA(1, 0, At, B0); PG8_MMA(1, 1, At, B1); PG8_BAR; PG8_SCHED;
            PG8_LDB(B0, 1, 0); PG8_LDB(B1, 1, 1); PG8_SCHED; PG8_LDA(At, 1, 0); PG8_STAGE(PG8_SA(0, 1), a2 + hstep, voffA);
            PG8_WAIT_V(8); PG8_WAIT_L(0); PG8_BAR; PG8_MMA(0, 0, At, B0); PG8_MMA(0, 1, At, B1); PG8_BAR; PG8_SCHED;
            PG8_LDA(At, 1, 1); PG8_STAGE(PG8_SB(1, 0), b3, voffB); PG8_STAGE(PG8_SB(1, 1), b3 + hstep, voffB); PG8_STAGE(PG8_SA(1, 0), a3, voffA);
            PG8_WAIT_V(8); PG8_WAIT_L(0); PG8_BAR; PG8_MMA(1, 0, At, B0); PG8_MMA(1, 1, At, B1); PG8_BAR; PG8_SCHED;
            } else {
            PG8_LDB(B0, 0, 0); PG8_SCHED; PG8_LDA(At, 0, 0); PG8_STAGE(PG8_SA(1, 1), a1 + hstep, voffA);
            PG8_WAIT_L(8); PG8_BAR; PG8_WAIT_L(0); PG8_MMA(0, 0, At, B0); PG8_BAR; PG8_SCHED;
            PG8_LDB(B1, 0, 1); PG8_STAGE(PG8_SB(0, 0), b2, voffB);
            PG8_BAR; PG8_WAIT_L(0); PG8_MMA(0, 1, At, B1); PG8_BAR;
            PG8_LDA(At, 0, 1); PG8_STAGE(PG8_SA(0, 0), a2, voffA);
            PG8_BAR; PG8_WAIT_L(0); PG8_MMA(1, 0, At, B0); PG8_BAR; PG8_SCHED;
            PG8_STAGE(PG8_SB(0, 1), b2 + hstep, voffB);
            PG8_WAIT_V(6); PG8_BAR; PG8_MMA(1, 1, At, B1); PG8_BAR;
            PG8_LDB(B0, 1, 0); PG8_SCHED; PG8_LDA(At, 1, 0); PG8_STAGE(PG8_SA(0, 1), a2 + hstep, voffA);
            PG8_WAIT_L(8); PG8_BAR; PG8_WAIT_L(0); PG8_MMA(0, 0, At, B0); PG8_BAR; PG8_SCHED;
            PG8_LDB(B1, 1, 1); PG8_STAGE(PG8_SB(1, 0), b3, voffB);
            PG8_BAR; PG8_WAIT_L(0); PG8_MMA(0, 1, At, B1); PG8_BAR;
            PG8_LDA(At, 1, 1); PG8_STAGE(PG8_SA(1, 0), a3, voffA);
            PG8_BAR; PG8_WAIT_L(0); PG8_MMA(1, 0, At, B0); PG8_BAR; PG8_SCHED;
            PG8_STAGE(PG8_SB(1, 1), b3 + hstep, voffB);
            PG8_WAIT_V(6); PG8_BAR; PG8_MMA(1, 1, At, B1); PG8_BAR;
            }
        }
        if constexpr (ALIGN_EPI) { if (wr == 0) PG8_BAR; }
        if constexpr (!Epi::AFTER_DRAIN) { E(acc, cur, wr, wc, fr, fq); S.done(cur); }
        if (!has_next) break;
#pragma unroll
        for (int a = 0; a < 2; ++a)
#pragma unroll
            for (int b = 0; b < 2; ++b)
#pragma unroll
                for (int m = 0; m < 4; ++m)
#pragma unroll
                    for (int n = 0; n < 2; ++n) acc[a][b][m][n] = (f32x4){0.f, 0.f, 0.f, 0.f};
        cur = nxt; cA = nA; cB = nB; ++ui;
        if constexpr (ALIGN_EPI) { if (wr == 1) PG8_BAR; }
    }
    PG8_WAIT_V(0);
    if constexpr (!ALIGN_EPI) { if (wr == 0) PG8_BAR; }
    PG8_BAR;
    if constexpr (Epi::AFTER_DRAIN) { E.fused(acc, cur, wr, wc, fr, fq, lds, wid, lane); S.done(cur); }
#undef PG8_SA
#undef PG8_SB
#undef PG8_STAGE
#undef PG8_LDA
#undef PG8_LDB
#undef PG8_MMA
#undef PG8_WAIT_V
#undef PG8_WAIT_L
#undef PG8_BAR
#undef PG8_SCHED
}
}
namespace att {
using bf16 = __hip_bfloat16;
constexpr int   D = 128, NW = 8, QBLK = 32, KVBLK = 64;
constexpr float SCALE = 0.088388347648318440f;
constexpr float THR = 8.f;
constexpr int SDEPTH = 2;
constexpr int LDQ = 1024, LDK = 256, LDO = 1024;
constexpr size_t SHM_V = KVBLK * D * 2, SHM_K = KVBLK * D * 2, SHM_ATTN = 2 * SHM_V + 2 * SHM_K + NW * 64 * 4;

using bf16x8 = __attribute__((ext_vector_type(8))) short;
using s16x4  = __attribute__((ext_vector_type(4))) short;
using f32x16 = __attribute__((ext_vector_type(16))) float;
using u32x4  = __attribute__((ext_vector_type(4))) unsigned;
#define KSWZ(row, colB) ((row) * 256 + ((colB) ^ (((row) & 7) << 4)))
#define SBAR() __builtin_amdgcn_sched_barrier(0)
__device__ __forceinline__ int crow(int r, int hi) { return (r & 3) + 8 * (r >> 2) + 4 * hi; }
__device__ __forceinline__ unsigned cvtpk(float lo, float hi) { unsigned r; asm volatile("v_cvt_pk_bf16_f32 %0, %1, %2" : "=v"(r) : "v"(lo), "v"(hi)); return r; }
__device__ __forceinline__ unsigned short f2bf(float f) { return (unsigned short)(cvtpk(f, 0.f) & 0xffffu); }
__device__ __forceinline__ float bf2f(unsigned short h) { return __uint_as_float((unsigned)h << 16); }

__device__ __forceinline__ void partialSM(f32x16& p0, f32x16& p1, float& m_reg, float& mn, float& alpha) {
  constexpr float C = SCALE * 1.4426950408889634f;
  float pmax = p0[0]; for (int r = 1; r < 16; ++r) pmax = fmaxf(pmax, p0[r]); for (int r = 0; r < 16; ++r) pmax = fmaxf(pmax, p1[r]);
  { auto rr = __builtin_amdgcn_permlane32_swap(__float_as_uint(pmax), __float_as_uint(pmax), false, false);
    pmax = fmaxf(__uint_as_float(rr[0]), __uint_as_float(rr[1])); }
  if (__builtin_expect(__all(pmax - m_reg <= THR / SCALE), 1)) { mn = m_reg; alpha = 1.f; }
  else { mn = fmaxf(m_reg, pmax); alpha = __builtin_amdgcn_exp2f((m_reg - mn) * C); m_reg = mn; }
  float mnC = -mn * C;
  for (int r = 0; r < 16; ++r) p0[r] = fmaf(p0[r], C, mnC); for (int r = 0; r < 16; ++r) p1[r] = fmaf(p1[r], C, mnC);
  for (int r = 0; r < 16; ++r) p0[r] = __builtin_amdgcn_exp2f(p0[r]);
}
__device__ __forceinline__ void finishSM(f32x16& p0, f32x16& p1, float alpha, float& l_reg, bf16x8& pa0, bf16x8& pa1, bf16x8& pa2, bf16x8& pa3) {
  for (int r = 0; r < 16; ++r) p1[r] = __builtin_amdgcn_exp2f(p1[r]);
  float ps = 0; for (int r = 0; r < 16; ++r) ps += p0[r]; for (int r = 0; r < 16; ++r) ps += p1[r];
  { auto rr = __builtin_amdgcn_permlane32_swap(__float_as_uint(ps), __float_as_uint(ps), false, false);
    ps = __uint_as_float(rr[0]) + __uint_as_float(rr[1]); }
  l_reg = l_reg * alpha + ps;
#define PK4(P, BASE, OUT) do { unsigned a0 = cvtpk(P[BASE + 0], P[BASE + 1]), a1 = cvtpk(P[BASE + 2], P[BASE + 3]);   \
    unsigned b0 = cvtpk(P[BASE + 4], P[BASE + 5]), b1 = cvtpk(P[BASE + 6], P[BASE + 7]);                              \
    auto r0 = __builtin_amdgcn_permlane32_swap(a0, b0, false, false); auto r1 = __builtin_amdgcn_permlane32_swap(a1, b1, false, false); \
    u32x4 w = {r0[0], r1[0], r0[1], r1[1]}; OUT = *reinterpret_cast<bf16x8*>(&w); } while (0)
  PK4(p0, 0, pa0); PK4(p0, 8, pa1); PK4(p1, 0, pa2); PK4(p1, 8, pa3);
#undef PK4
}
__device__ __forceinline__ void qkt(f32x16& p0, f32x16& p1, const bf16* Ks, const bf16x8* qr, int r32, int hi) {
  p0 = f32x16{}; p1 = f32x16{};
  for (int d0 = 0; d0 < 8; ++d0) { int cb = (d0 * 16 + hi * 8) * 2;
    bf16x8 b0 = *reinterpret_cast<const bf16x8*>((const char*)Ks + KSWZ(r32, cb));
    bf16x8 b1 = *reinterpret_cast<const bf16x8*>((const char*)Ks + KSWZ(32 + r32, cb));
    p0 = __builtin_amdgcn_mfma_f32_32x32x16_bf16(b0, qr[d0], p0, 0, 0, 0);
    p1 = __builtin_amdgcn_mfma_f32_32x32x16_bf16(b1, qr[d0], p1, 0, 0, 0); }
}
__device__ __forceinline__ int v_st(int k, int c) { const int kk = (k & ~0xC) | ((k & 4) << 1) | ((k & 8) >> 1); return ((kk >> 3) * 4 + (c >> 5)) * 512 + ((kk & 7) * 32 + (c & 31)) * 2; }
__device__ __forceinline__ int v_rd_base(int lane) { return ((lane & 3) << 3) | (((lane >> 2) & 3) << 6) | (((lane >> 4) & 1) << 5) | (((lane >> 5) & 1) << 8); }
constexpr int v_rd_off(int d0, int ks, int half) { return d0 * 512 + ks * 4096 + half * 2048; }
template <int OFF> __device__ __forceinline__ s16x4 tr_read(int vb) {
  s16x4 r; asm volatile("ds_read_b64_tr_b16 %0, %1 offset:%2" : "=&v"(r) : "v"(vb), "i"(OFF) : "memory"); return r;
}
template <int D0> __device__ __forceinline__ void pv_one(f32x16& od, int vb, bf16x8 pa0, bf16x8 pa1, bf16x8 pa2, bf16x8 pa3) {
  const s16x4 l0 = tr_read<v_rd_off(D0, 0, 0)>(vb), h0 = tr_read<v_rd_off(D0, 0, 1)>(vb), l1 = tr_read<v_rd_off(D0, 1, 0)>(vb), h1 = tr_read<v_rd_off(D0, 1, 1)>(vb);
  const s16x4 l2 = tr_read<v_rd_off(D0, 2, 0)>(vb), h2 = tr_read<v_rd_off(D0, 2, 1)>(vb), l3 = tr_read<v_rd_off(D0, 3, 0)>(vb), h3 = tr_read<v_rd_off(D0, 3, 1)>(vb);
  asm volatile("s_waitcnt lgkmcnt(0)" ::: "memory"); SBAR();
#define PK(L, H) (bf16x8){L[0], L[1], L[2], L[3], H[0], H[1], H[2], H[3]}
  od = __builtin_amdgcn_mfma_f32_32x32x16_bf16(pa0, PK(l0, h0), od, 0, 0, 0);
  od = __builtin_amdgcn_mfma_f32_32x32x16_bf16(pa1, PK(l1, h1), od, 0, 0, 0);
  od = __builtin_amdgcn_mfma_f32_32x32x16_bf16(pa2, PK(l2, h2), od, 0, 0, 0);
  od = __builtin_amdgcn_mfma_f32_32x32x16_bf16(pa3, PK(l3, h3), od, 0, 0, 0);
#undef PK
}
__device__ __forceinline__ void pv_d0(f32x16* o, int vb, bf16x8 pa0, bf16x8 pa1, bf16x8 pa2, bf16x8 pa3) {
  pv_one<0>(o[0], vb, pa0, pa1, pa2, pa3); pv_one<1>(o[1], vb, pa0, pa1, pa2, pa3); pv_one<2>(o[2], vb, pa0, pa1, pa2, pa3); pv_one<3>(o[3], vb, pa0, pa1, pa2, pa3);
}

__device__ __forceinline__ void attn_dense_body(const bf16* Qb, const bf16* __restrict__ Kh, const bf16* __restrict__ Vh, bf16* Ob, int seq, char* lds) {
  int tid_ = threadIdx.x; asm volatile("" : "+v"(tid_));
  const int tid = tid_, wid = tid >> 6, lane = tid & 63, r32 = lane & 31, hi = lane >> 5;
  bf16* V_lds = (bf16*)lds; bf16* K_lds = (bf16*)(lds + 2 * SHM_V);
  float* ws = (float*)(lds + 2 * SHM_V + 2 * SHM_K) + wid * 64; float* li_l = ws; float* al_l = ws + 32;
  float m_reg = -1e30f, l_reg = 0; f32x16 o[4] = {}; bf16x8 qr[8];
  const bf16* Qw = Qb + (long)(wid * QBLK + r32) * LDQ + hi * 8;
#pragma unroll
  for (int d0 = 0; d0 < 8; ++d0) qr[d0] = *reinterpret_cast<const bf16x8*>(Qw + d0 * 16);
  const int sr = tid >> 4, sc = (tid & 15) * 8, vst0 = v_st(sr, sc), vst1 = v_st(32 + sr, sc);
  const int vb0 = (int)(uintptr_t)V_lds + v_rd_base(lane);
  struct { bf16x8 vs0, vs1, ks0, ks1; } sr_[SDEPTH];
#define SLOAD(i, k0) do { sr_[i].vs0 = *reinterpret_cast<const bf16x8*>(&Vh[(long)((k0) + sr) * LDK + sc]); sr_[i].vs1 = *reinterpret_cast<const bf16x8*>(&Vh[(long)((k0) + 32 + sr) * LDK + sc]); \
    sr_[i].ks0 = *reinterpret_cast<const bf16x8*>(&Kh[(long)((k0) + sr) * LDK + sc]); sr_[i].ks1 = *reinterpret_cast<const bf16x8*>(&Kh[(long)((k0) + 32 + sr) * LDK + sc]); } while (0)
#define SWRITE(b, i) do { *(bf16x8*)((char*)V_lds + (b) * SHM_V + vst0) = sr_[i].vs0;          \
    *(bf16x8*)((char*)V_lds + (b) * SHM_V + vst1) = sr_[i].vs1; int kc = sc * 2;               \
    *(bf16x8*)((char*)K_lds + (b) * SHM_K + KSWZ(sr, kc)) = sr_[i].ks0;                       \
    *(bf16x8*)((char*)K_lds + (b) * SHM_K + KSWZ(32 + sr, kc)) = sr_[i].ks1; } while (0)
#define SWAIT() do { asm volatile("s_waitcnt vmcnt(4)" ::: "memory"); } while (0)
#define RESC(a) do { if (__any((a) < 1.f)) { if (hi == 0) al_l[r32] = (a); asm volatile("s_waitcnt lgkmcnt(0)" ::: "memory"); \
    for (int d = 0; d < 4; ++d) for (int r = 0; r < 16; ++r) o[d][r] *= al_l[crow(r, hi)]; } } while (0)
  f32x16 pA0, pA1, pB0, pB1; float mnA, mnB, alA, alB; bf16x8 pa0, pa1, pa2, pa3; const int NT = seq / KVBLK;
  constexpr int SE = 0, SO = SDEPTH - 1;
  SLOAD(SE, 0); asm volatile("s_waitcnt vmcnt(0)" ::: "memory"); SWRITE(0, SE); __syncthreads();
  qkt(pA0, pA1, K_lds, qr, r32, hi); partialSM(pA0, pA1, m_reg, mnA, alA);
  SLOAD(SO, KVBLK); if (2 < NT) SLOAD(SE, 2 * KVBLK);
  SWAIT(); SWRITE(1, SO); __syncthreads();
  for (int j = 1; j + 1 < NT; j += 2) {
    SBAR(); qkt(pB0, pB1, (bf16*)((char*)K_lds + SHM_K), qr, r32, hi);
    finishSM(pA0, pA1, alA, l_reg, pa0, pa1, pa2, pa3); SBAR();
    SLOAD(SO, (j + SDEPTH) * KVBLK); SBAR();
    pv_d0(o, vb0, pa0, pa1, pa2, pa3); partialSM(pB0, pB1, m_reg, mnB, alB);
    __syncthreads(); SWAIT(); SWRITE(0, SE);
    RESC(alB); __syncthreads();
    SBAR(); qkt(pA0, pA1, K_lds, qr, r32, hi);
    finishSM(pB0, pB1, alB, l_reg, pa0, pa1, pa2, pa3); SBAR();
    if (j + 3 < NT) SLOAD(SE, (j + 1 + SDEPTH) * KVBLK); SBAR();
    pv_d0(o, vb0 + (int)SHM_V, pa0, pa1, pa2, pa3); partialSM(pA0, pA1, m_reg, mnA, alA);
    __syncthreads(); SWAIT(); SWRITE(1, SO);
    RESC(alA); __syncthreads();
  }
  SBAR(); qkt(pB0, pB1, (bf16*)((char*)K_lds + SHM_K), qr, r32, hi);
  finishSM(pA0, pA1, alA, l_reg, pa0, pa1, pa2, pa3); SBAR();
  pv_d0(o, vb0, pa0, pa1, pa2, pa3); partialSM(pB0, pB1, m_reg, mnB, alB);
  __syncthreads(); RESC(alB);
  finishSM(pB0, pB1, alB, l_reg, pa0, pa1, pa2, pa3); SBAR();
  pv_d0(o, vb0 + (int)SHM_V, pa0, pa1, pa2, pa3);
  if (hi == 0) li_l[r32] = l_reg; asm volatile("s_waitcnt lgkmcnt(0)" ::: "memory");
  float rli[16];
#pragma unroll
  for (int r = 0; r < 16; ++r) rli[r] = __builtin_amdgcn_rcpf(li_l[crow(r, hi)]);
  unsigned short* Ow = (unsigned short*)Ob + (long)(wid * QBLK) * LDO;
#pragma unroll
  for (int r = 0; r < 16; ++r) { int orow = crow(r, hi);
    for (int d0 = 0; d0 < 4; ++d0) Ow[(long)orow * LDO + d0 * 32 + r32] = f2bf(o[d0][r] * rli[r]); }
  __syncthreads();
#undef SLOAD
#undef SWRITE
#undef SWAIT
#undef RESC
}
}
constexpr int NWAVES = 8;
constexpr int M = 16384, D = 1024, FF = 2816, NGU = 2 * FF, NIN = 1536, NQKV = 1536;
constexpr size_t MiB = 1u << 20;
constexpr size_t WS_CTL = 0, CTL_ZERO_BYTES = 1 * MiB;
constexpr size_t WS_ROWSS = 128 * 1024;
constexpr size_t WS_TAB = 1 * MiB;
constexpr size_t TAB_ROPE = WS_TAB;
constexpr size_t TAB_TW = WS_TAB + 96 * 1024;
constexpr size_t TAB_P1 = WS_TAB + 224 * 1024;
constexpr size_t TAB_P2 = WS_TAB + 288 * 1024;
constexpr size_t TAB_WS = WS_TAB + 416 * 1024;
constexpr size_t WS_WGU = 2 * MiB;
constexpr size_t WS_WD = WS_WGU + 44 * MiB;
constexpr size_t WS_WIN = WS_WD + 22 * MiB;
constexpr size_t WS_WOUT = WS_WIN + 3 * MiB;
constexpr size_t WS_WQKV = WS_WOUT + 2 * MiB;
constexpr size_t WS_WO = WS_WQKV + 3 * MiB;
constexpr size_t WS_XB = WS_WO + 2 * MiB;
constexpr size_t WS_ACT = WS_XB + 32 * MiB;
constexpr size_t WS_AB = WS_ACT, WS_GV = WS_ACT + 32 * MiB, WS_BT = WS_ACT + 48 * MiB;
constexpr size_t WS_QB = WS_ACT, WS_KB = WS_ACT + 32 * MiB, WS_VB = WS_ACT + 40 * MiB;
constexpr size_t WS_END = WS_ACT + 88 * MiB;
static_assert(WS_XB == 78 * MiB && WS_END <= 256 * MiB && WS_BT + 32 * MiB <= WS_END, "d_ws map");
constexpr int CW_TMO = 0, CW_BAR = 4096;
constexpr int RING_BYTES = 131072, LDSCTL_OFF = RING_BYTES, MISC_OFF = LDSCTL_OFF + 320, LDS_BYTES = 147456;

#define GAS __attribute__((address_space(1)))
#define LAS __attribute__((address_space(3)))
typedef unsigned short bf16;
typedef unsigned v4u __attribute__((ext_vector_type(4)));
typedef float f32x4 __attribute__((ext_vector_type(4)));
typedef short bf16x8 __attribute__((ext_vector_type(8)));
typedef float f32x16 __attribute__((ext_vector_type(16)));
typedef GAS unsigned gu32;
#define RLX_AGENT __ATOMIC_RELAXED, __HIP_MEMORY_SCOPE_AGENT
#define LDS_WAIT() asm volatile("s_waitcnt lgkmcnt(0)" ::: "memory")
#define VM_WAIT() asm volatile("s_waitcnt vmcnt(0)" ::: "memory")
__device__ __forceinline__ unsigned f2bf(float f) { unsigned u = __builtin_bit_cast(unsigned, f); return (u + 0x7fffu + ((u >> 16) & 1u)) >> 16; }
__device__ __forceinline__ unsigned pk2(float lo, float hi) { return f2bf(lo) | (f2bf(hi) << 16); }
__device__ __forceinline__ float bf2f(unsigned h) { return __uint_as_float(h << 16); }

#define XB_TMO      128
#define XB_XCNT(j)  (256  + 64 * (j))
#define XB_XSUB(j)  (1280 + 64 * (j))
#define XB_XGEN(j)  (2304 + 64 * (j))
#define XB_TOP      3328
#define XB_TOPGEN   3392
#define XCD_BAR_WORDS 3456
#define XB_SPIN_CAP (1u << 18)

__device__ __forceinline__ unsigned xb_ld(unsigned* p)              { return __hip_atomic_load(p, __ATOMIC_RELAXED, __HIP_MEMORY_SCOPE_AGENT); }
__device__ __forceinline__ unsigned xb_add(unsigned* p, unsigned v) { return __hip_atomic_fetch_add(p, v, __ATOMIC_RELAXED, __HIP_MEMORY_SCOPE_AGENT); }
__device__ __forceinline__ unsigned xb_xcc_id() { return (unsigned)__builtin_amdgcn_s_getreg((3 << 11) | 20) & 0xFu; }
#define XB_SPIN(cond, bar) do { unsigned _sp = 0; while (cond) { __builtin_amdgcn_s_sleep(1); \
    if ((++_sp & 255u) == 0u) { if (xb_ld(&(bar)[XB_TMO])) break; if (_sp > XB_SPIN_CAP) { atomicAdd(&(bar)[XB_TMO], 1u); break; } } } } while (0)

struct XcdBarrier {
    unsigned* bar; unsigned x;
    volatile LAS unsigned* st;
};

__device__ __forceinline__ XcdBarrier xcd_barrier_post(unsigned* bar, volatile LAS unsigned* st) {
    XcdBarrier b; b.bar = bar; b.x = xb_xcc_id(); b.st = st;
    if (threadIdx.x == 0) (void)xb_add(&bar[XB_XCNT(b.x)], 1u);
    return b;
}
__device__ __forceinline__ void xcd_barrier_complete(unsigned* bar, unsigned x, unsigned& nloc, unsigned& nx) {
    const unsigned G = gridDim.x * gridDim.y * gridDim.z;
    unsigned sum, cnt, mine, sp = 0u;
    for (;;) {
        sum = 0u; cnt = 0u; mine = 0u;
#pragma unroll
        for (unsigned j = 0; j < 16; ++j) { const unsigned c = xb_ld(&bar[XB_XCNT(j)]); sum += c; cnt += (c > 0u) ? 1u : 0u; mine = (j == x) ? c : mine; }
        if (sum == G) break;
        __builtin_amdgcn_s_sleep(1);
        if ((++sp & 255u) == 0u) { if (xb_ld(&bar[XB_TMO])) break; if (sp > XB_SPIN_CAP) { atomicAdd(&bar[XB_TMO], 1u); break; } }
    }
    nloc = mine > 0u ? mine : 1u; nx = cnt > 0u ? cnt : 1u;
}

__device__ __forceinline__ void xcd_barrier(const XcdBarrier& b) {
    asm volatile("s_waitcnt vmcnt(0)" ::: "memory");
    __syncthreads();
    if (threadIdx.x == 0) {
        unsigned* bar = b.bar;
        __builtin_amdgcn_s_waitcnt(0);
        unsigned nloc = b.st[0], nx = b.st[1];
        if (nloc == 0u) { xcd_barrier_complete(bar, b.x, nloc, nx); b.st[0] = nloc; b.st[1] = nx; }
        const unsigned old = xb_add(&bar[XB_XSUB(b.x)], 1u);
        const unsigned gen = old / nloc;
        if (old + 1u == (gen + 1u) * nloc) {
            __builtin_amdgcn_fence(__ATOMIC_RELEASE, "agent");
            asm volatile("s_waitcnt vmcnt(0)" ::: "memory");
            const unsigned og = xb_add(&bar[XB_TOP], 1u);
            const unsigned tg = og / nx;
            if (og + 1u == (tg + 1u) * nx) xb_add(&bar[XB_TOPGEN], 1u);
            else XB_SPIN(xb_ld(&bar[XB_TOPGEN]) == tg, bar);
            __builtin_amdgcn_fence(__ATOMIC_ACQUIRE, "agent");
            xb_add(&bar[XB_XGEN(b.x)], 1u);
            asm volatile("s_waitcnt vmcnt(0)" ::: "memory");
        } else {
            XB_SPIN(xb_ld(&bar[XB_XGEN(b.x)]) == gen, bar);
            __builtin_amdgcn_fence(__ATOMIC_ACQUIRE, "agent");
            asm volatile("s_waitcnt vmcnt(0)" ::: "memory");
        }
    }
    __syncthreads();
}


struct Args { const float* in[20]; float* out; unsigned char* ws; const float* xsrc; int ph_lo, ph_hi, li, ss_idx; };
struct Frame {
    LAS unsigned char* lds; int tid, lane, wave, vcu, G;
    float* out; unsigned char* ws;
};
#ifndef MK_PHASES
#define MK_PHASES 0x3ffff
#endif
__device__ __forceinline__ float wave_sum(float v) {
#pragma unroll
    for (int o = 1; o < 64; o <<= 1) v += __shfl_xor(v, o);
    return v;
}
template <class Src>
__device__ __forceinline__ void p0_titem(Src src, bf16* dst, int dld, LAS float* scr, int lane) {
#pragma unroll 8
    for (int i = 0; i < 32; ++i) { const int kk = 2 * i + (lane >> 5); scr[kk * 33 + (lane & 31)] = src(kk, lane & 31); }
    LDS_WAIT(); asm volatile("" ::: "memory");
    const int c = lane & 7;
#pragma unroll
    for (int j = 0; j < 4; ++j) { const int n = (lane >> 3) + 8 * j; const LAS float* s = scr + (8 * c) * 33 + n;
        v4u o; o.x = pk2(s[0 * 33], s[1 * 33]); o.y = pk2(s[2 * 33], s[3 * 33]); o.z = pk2(s[4 * 33], s[5 * 33]); o.w = pk2(s[6 * 33], s[7 * 33]);
        *(GAS v4u*)(dst + (size_t)n * dld + 8 * c) = o; }
    LDS_WAIT(); asm volatile("" ::: "memory");
}
__device__ __forceinline__ void p0_plain(const float* W, int ldw, int N, const float* gain, bf16* dst, int dld, int gu_half  , LAS float* scr, int item, int lane) {
    const int nblk = N / 32, kb = item / nblk, nb = item % nblk, k0 = 64 * kb, n0 = 32 * nb;
    const int drow0 = gu_half < 0 ? n0 : 256 * (n0 >> 7) + 128 * gu_half + (n0 & 127);
    const float* Wp = W + (size_t)k0 * ldw + n0; const float* gp = gain ? gain + k0 : nullptr;
    p0_titem([=](int kk, int nn) { const float w = Wp[(size_t)kk * ldw + nn]; return gp ? w * gp[kk] : w; }, dst + (size_t)drow0 * dld + k0, dld, scr, lane);
}
__device__ __forceinline__ void p0_prologue(Frame& F, const Args& A) {
    LAS float* scr = (LAS float*)(F.lds + F.wave * 16384);
    const int gw = F.vcu * NWAVES + F.wave, NGW = F.G * NWAVES, lane = F.lane;
    unsigned char* ws = F.ws;
    LAS float* ctab = scr + 64 * 33 + 16;
    { float s, c; sincospif((float)lane / 64.f, &s, &c); ctab[lane] = c; sincospif((float)(lane + 64) / 64.f, &s, &c); ctab[lane + 64] = c; }
    LDS_WAIT();
    constexpr int I_G = 16 * 88, I_D = 44 * 32, I_F = 3 * I_G;
    constexpr int I_INUV = 16 * 32, I_OUTG = 8 * 32, I_OUTF = 8 * 32, I_QKV = 16 * 48, I_O = 16 * 32, I_FOLD = 128 * 4 * 2;
    constexpr int NITEMS = 4 * I_F + I_INUV + I_OUTG + I_OUTF + I_QKV + I_O + I_FOLD;
    for (int it = gw; it < NITEMS; it += NGW) {
        int r = it;
        if (r < 4 * I_F) { const int f = r / I_F; r -= f * I_F; const int L = f >> 1, second = f & 1;
            const float* gn = A.in[second ? 15 : 1] + L * D; const float* wg = A.in[second ? 16 : 2] + (size_t)L * D * FF; const float* wu = A.in[second ? 17 : 3] + (size_t)L * D * FF; const float* wd = A.in[second ? 18 : 4] + (size_t)L * D * FF;
            bf16* wgu = (bf16*)(ws + WS_WGU) + (size_t)f * NGU * D; bf16* wdt = (bf16*)(ws + WS_WD) + (size_t)f * D * FF;
            if (r < I_G) { p0_plain(wg, FF, FF, gn, wgu, D, 0, scr, r, lane); continue; } r -= I_G;
            if (r < I_G) { p0_plain(wu, FF, FF, gn, wgu, D, 1, scr, r, lane); continue; } r -= I_G;
            p0_plain(wd, D, D, nullptr, wdt, FF, -1, scr, r, lane); continue; }
        r -= 4 * I_F;
        if (r < I_INUV) { p0_plain(A.in[6] + 512, NIN, 1024, A.in[5], (bf16*)(ws + WS_WIN) + (size_t)512 * D, D, -1, scr, r, lane); continue; } r -= I_INUV;
        if (r < I_OUTG) { p0_plain(A.in[10] + (size_t)512 * D, D, D, nullptr, (bf16*)(ws + WS_WOUT) + 512, D, -1, scr, r, lane); continue; } r -= I_OUTG;
        if (r < I_OUTF) {
            const int nblk = D / 32, kb = r / nblk, nb = r % nblk, k0 = 64 * kb, n0 = 32 * nb; const float* wo = A.in[10]; const float sc = 6.9053396600248786e-4f;
            p0_titem([=](int kk, int nn) { const int kp = k0 + kk, g = kp >> 7, c = kp & 127; const float* w = wo + (size_t)(g * 128) * D + n0 + nn;
                    float v; if (c == 0) v = w[0]; else if (c == 64) v = w[(size_t)64 * D]; else if (c < 64) v = w[(size_t)c * D] + w[(size_t)(128 - c) * D]; else { const int j = c - 64; v = w[(size_t)(128 - j) * D] - w[(size_t)j * D]; }
                    return v * sc; }, (bf16*)(ws + WS_WOUT) + (size_t)n0 * D + k0, D, scr, lane);
            continue; }
        r -= I_OUTF;
        if (r < I_QKV) { p0_plain(A.in[11], NQKV, NQKV, A.in[5] + D, (bf16*)(ws + WS_WQKV), D, -1, scr, r, lane); continue; } r -= I_QKV;
        if (r < I_O) { p0_plain(A.in[14], D, D, nullptr, (bf16*)(ws + WS_WO), D, -1, scr, r, lane); continue; } r -= I_O;
        {
            const int kb = r >> 3, g = (r >> 1) & 3, ch = r & 1, k0 = 8 * kb, c = 64 * ch + lane;
            const int f = c <= 64 ? c : c - 64, ph = c <= 64 ? 0 : 32;
            const float* wi = A.in[6] + (size_t)k0 * NIN + g * 128; float a[8] = {0.f, 0.f, 0.f, 0.f, 0.f, 0.f, 0.f, 0.f};
            for (int d = 0; d < 128; ++d) { const float dm = ctab[(d * f - ph) & 127];
#pragma unroll
                for (int j = 0; j < 8; ++j) a[j] = fmaf(wi[(size_t)j * NIN + d], dm, a[j]); }
            const float* gn = A.in[5] + k0;
            v4u o; o.x = pk2(a[0] * gn[0], a[1] * gn[1]); o.y = pk2(a[2] * gn[2], a[3] * gn[3]); o.z = pk2(a[4] * gn[4], a[5] * gn[5]); o.w = pk2(a[6] * gn[6], a[7] * gn[7]);
            *(GAS v4u*)((bf16*)(ws + WS_WIN) + (size_t)(g * 128 + c) * D + k0) = o; }
    }
    const int gt = gw * 64 + lane, NGT = NGW * 64;
    for (int i = gt; i < 320 * 32; i += NGT) { const int p = i >> 5, j = i & 31; const float pos = (float)(p < 256 ? p : p - 256); const float inv = powf(10000.f, -(float)j / 32.f); const float ang = pos * inv;
        float2 cs; cs.x = cosf(ang); cs.y = sinf(ang); ((float2*)(ws + TAB_ROPE))[i] = cs; }
    for (int i = gt; i < 128 * 128; i += NGT) { const int n2 = i >> 7, k1 = i & 127; float s, c; sincospif((float)(n2 * k1) / 8192.f, &s, &c); float2 cs; cs.x = c; cs.y = s; ((float2*)(ws + TAB_TW))[i] = cs; }
    for (int i = gt; i < 256 * 128; i += NGT) { const int row = i >> 7, n1 = i & 127, k1 = row >> 1; float s, c; sincospif((float)((n1 * k1) & 127) / 64.f, &s, &c);
        ((bf16*)(ws + TAB_P1))[i] = (bf16)f2bf((row & 1) ? -s : c); }
    for (int i = gt; i < 256 * 256; i += NGT) { const int row = i >> 8, kk = i & 255, k2 = row >> 1, n2 = kk & 127; float s, c; sincospif((float)((n2 * k2) & 127) / 64.f, &s, &c);
        const float v = (row & 1) ? (kk < 128 ? s : -c) : (kk < 128 ? c : s); ((bf16*)(ws + TAB_P2))[i] = (bf16)f2bf(v); }
    for (int i = gt; i < 4 * 128 * 128; i += NGT) ((bf16*)(ws + TAB_WS))[i] = (bf16)f2bf(A.in[8][i]);
}
__device__ __forceinline__ void refresh_rows(Frame& F, const float* X, float* ss) {
    const int gw = F.vcu * NWAVES + F.wave, NGW = F.G * NWAVES;
    for (int m = gw; m < M; m += NGW) { const GAS f32x4* xr = (const GAS f32x4*)(X + (size_t)m * D) + F.lane; f32x4 v[4]; float s = 0.f;
#pragma unroll
        for (int j = 0; j < 4; ++j) { v[j] = xr[64 * j]; s += (v[j].x * v[j].x + v[j].y * v[j].y) + (v[j].z * v[j].z + v[j].w * v[j].w); }
        s = wave_sum(s); if (F.lane == 0) ss[m] = s;
        GAS unsigned long long* o8 = (GAS unsigned long long*)((bf16*)(F.ws + WS_XB) + (size_t)m * D) + F.lane;
#pragma unroll
        for (int j = 0; j < 4; ++j) o8[64 * j] = (unsigned long long)pk2(v[j].x, v[j].y) | ((unsigned long long)pk2(v[j].z, v[j].w) << 32); }
}
__device__ __forceinline__ void final_rows(Frame& F, const float* ss, const float* g) {
    const int gw = F.vcu * NWAVES + F.wave, NGW = F.G * NWAVES;
    for (int m = gw; m < M; m += NGW) { GAS f32x4* xr = (GAS f32x4*)(F.out + (size_t)m * D) + F.lane; const float r = __builtin_amdgcn_rsqf(ss[m] * (1.f / D) + 1e-6f);
#pragma unroll
        for (int j = 0; j < 4; ++j) { const f32x4 gv = ((const GAS f32x4*)g)[64 * j + F.lane]; xr[64 * j] = xr[64 * j] * r * gv; } }
}
__device__ __forceinline__ void rope_rows(Frame& F, const Args& A) {
    const int gw = F.vcu * NWAVES + F.wave, NGW = F.G * NWAVES, lane = F.lane;
    const float2* rt = (const float2*)(F.ws + TAB_ROPE);
    for (int it = gw; it < M * 10; it += NGW) { const int t = it / 10, h = it - t * 10;
        unsigned* p = h < 8 ? (unsigned*)((bf16*)(F.ws + WS_QB) + (size_t)t * 1024 + h * 128) + lane : (unsigned*)((bf16*)(F.ws + WS_KB) + (size_t)t * 256 + (h - 8) * 128) + lane;
        const float* g = h < 8 ? A.in[12] : A.in[13];
        const unsigned w = *p; float x0 = bf2f(w & 0xffffu), x1 = bf2f(w >> 16);
        const float rs = __builtin_amdgcn_rsqf(wave_sum(x0 * x0 + x1 * x1) * (1.f / 128.f) + 1e-6f);
        x0 = x0 * rs * g[2 * lane]; x1 = x1 * rs * g[2 * lane + 1];
        const float2 cs = lane < 32 ? rt[(t >> 6) * 32 + lane] : rt[(256 + (t & 63)) * 32 + lane - 32];
        *p = pk2(x0 * cs.x - x1 * cs.y, x0 * cs.y + x1 * cs.x); }
}
__device__ __forceinline__ void pv_stage(const bf16* src, size_t rstride, int nrows, char* lds, int tid) {
    const int sr = tid >> 4, sc = (tid & 15) * 8;
    for (int r = sr; r < nrows; r += 32) { const bf16x8 v = *(const bf16x8*)(src + (size_t)r * rstride + sc);
        *(bf16x8*)(lds + (r >> 6) * 16384 + att::v_st(r & 63, sc)) = v; }
}
__device__ __forceinline__ void fourier1_phase(Frame& F) {
    char* lds = (char*)F.lds; const int tid = F.tid, w = F.wave, lane = F.lane, r32 = lane & 31, hi = lane >> 5;
    const bf16* P1 = (const bf16*)(F.ws + TAB_P1); const bf16* AB = (const bf16*)(F.ws + WS_AB); bf16* BT = (bf16*)(F.ws + WS_BT); const float2* TW = (const float2*)(F.ws + TAB_TW);
    bf16x8 pa[8];
#pragma unroll
    for (int ks = 0; ks < 8; ++ks) pa[ks] = *(const bf16x8*)(P1 + (size_t)(32 * w + r32) * 128 + 16 * ks + 8 * hi);
    const int vb = (int)(uintptr_t)lds + att::v_rd_base(lane);
    for (int it = F.vcu; it < 512; it += F.G) { const int n2 = it >> 2, cb = it & 3;
        __syncthreads();
        pv_stage(AB + (size_t)n2 * 1024 + cb * 128, (size_t)128 * 1024, 128, lds, tid);
        __syncthreads();
        f32x16 o[4] = {};
        att::pv_d0(o, vb, pa[0], pa[1], pa[2], pa[3]); att::pv_d0(o, vb + 16384, pa[4], pa[5], pa[6], pa[7]);
#pragma unroll
        for (int t = 0; t < 8; ++t) { const int k1 = (32 * w + att::crow(2 * t, hi)) >> 1; const float2 cs = TW[n2 * 128 + k1];
            bf16* dr = BT + ((size_t)(k1 * 2) * 128 + n2) * 512 + cb * 128 + r32; bf16* di = dr + (size_t)128 * 512;
#pragma unroll
            for (int d0 = 0; d0 < 4; ++d0) { const float re = o[d0][2 * t], im = o[d0][2 * t + 1];
                dr[d0 * 32] = (bf16)f2bf(re * cs.x + im * cs.y); di[d0 * 32] = (bf16)f2bf(im * cs.x - re * cs.y); } }
    }
}
__device__ __forceinline__ void fourier2_phase(Frame& F) {
    char* lds = (char*)F.lds; const int tid = F.tid, w = F.wave, lane = F.lane, r32 = lane & 31, hi = lane >> 5;
    const bf16* P2 = (const bf16*)(F.ws + TAB_P2); bf16* AB = (bf16*)(F.ws + WS_AB); const bf16* BT = (const bf16*)(F.ws + WS_BT);
    bf16x8 pa[16];
#pragma unroll
    for (int ks = 0; ks < 16; ++ks) pa[ks] = *(const bf16x8*)(P2 + (size_t)(32 * w + r32) * 256 + 16 * ks + 8 * hi);
    const int vb = (int)(uintptr_t)lds + att::v_rd_base(lane);
    for (int it = F.vcu; it < 512; it += F.G) { const int k1 = it >> 2, cb = it & 3;
        __syncthreads();
        pv_stage(BT + (size_t)k1 * 256 * 512 + cb * 128, 512, 256, lds, tid);
        __syncthreads();
        f32x16 o[4] = {};
        att::pv_d0(o, vb, pa[0], pa[1], pa[2], pa[3]); att::pv_d0(o, vb + 16384, pa[4], pa[5], pa[6], pa[7]);
        att::pv_d0(o, vb + 32768, pa[8], pa[9], pa[10], pa[11]); att::pv_d0(o, vb + 49152, pa[12], pa[13], pa[14], pa[15]);
#pragma unroll
        for (int t = 0; t < 8; ++t) { const int k2 = (32 * w + att::crow(2 * t, hi)) >> 1; bf16* dst = AB + (size_t)(k1 + 128 * k2) * 1024 + cb * 128 + r32;
#pragma unroll
            for (int d0 = 0; d0 < 4; ++d0) { const int c = 32 * d0 + r32; dst[d0 * 32] = (bf16)f2bf(c <= 64 ? o[d0][2 * t] : o[d0][2 * t + 1]); } }
    }
}
__device__ __forceinline__ void gate_phase(Frame& F, const Args& A) {
    char* lds = (char*)F.lds; const int tid = F.tid, w = F.wave, lane = F.lane, r32 = lane & 31, hi = lane >> 5;
    const bf16* WS = (const bf16*)(F.ws + TAB_WS); bf16* AB = (bf16*)(F.ws + WS_AB); const bf16* GV = (const bf16*)(F.ws + WS_GV);
    const int vb = (int)(uintptr_t)lds + att::v_rd_base(lane); const int rb = w & 3, ch = w >> 2;
    const int sr = tid >> 4, sc = (tid & 15) * 8;
    for (int it = F.vcu; it < 512; it += F.G) { const int c = it >> 2, g = it & 3;
        __syncthreads();
        {
            const float* vn = A.in[7] + g * 128 + sc; float gn[8];
#pragma unroll
            for (int j = 0; j < 8; ++j) gn[j] = vn[j];
#pragma unroll
            for (int p = 0; p < 4; ++p) { const int r = sr + 32 * p; const bf16x8 v = *(const bf16x8*)(GV + (size_t)(128 * c + r) * 512 + g * 128 + sc); float x[8]; float s = 0.f;
#pragma unroll
                for (int j = 0; j < 8; ++j) { x[j] = bf2f((unsigned short)v[j]); s += x[j] * x[j]; }
                s += __shfl_xor(s, 1); s += __shfl_xor(s, 2); s += __shfl_xor(s, 4); s += __shfl_xor(s, 8);
                const float rs = __builtin_amdgcn_rsqf(s * (1.f / 128.f) + 1e-6f);
                v4u o; o.x = pk2(x[0] * rs * gn[0], x[1] * rs * gn[1]); o.y = pk2(x[2] * rs * gn[2], x[3] * rs * gn[3]); o.z = pk2(x[4] * rs * gn[4], x[5] * rs * gn[5]); o.w = pk2(x[6] * rs * gn[6], x[7] * rs * gn[7]);
                *(v4u*)(lds + (r >> 6) * 16384 + att::v_st(r & 63, sc)) = o; } }
        bf16x8 pa[8];
#pragma unroll
        for (int ks = 0; ks < 8; ++ks) pa[ks] = *(const bf16x8*)(WS + (size_t)(g * 128 + 32 * rb + r32) * 128 + 16 * ks + 8 * hi);
        __syncthreads();
        f32x16 o[2] = {};
        if (ch == 0) { att::pv_one<0>(o[0], vb, pa[0], pa[1], pa[2], pa[3]); att::pv_one<1>(o[1], vb, pa[0], pa[1], pa[2], pa[3]);
                       att::pv_one<0>(o[0], vb + 16384, pa[4], pa[5], pa[6], pa[7]); att::pv_one<1>(o[1], vb + 16384, pa[4], pa[5], pa[6], pa[7]); }
        else         { att::pv_one<2>(o[0], vb, pa[0], pa[1], pa[2], pa[3]); att::pv_one<3>(o[1], vb, pa[0], pa[1], pa[2], pa[3]);
                       att::pv_one<2>(o[0], vb + 16384, pa[4], pa[5], pa[6], pa[7]); att::pv_one<3>(o[1], vb + 16384, pa[4], pa[5], pa[6], pa[7]); }
        const float* bs = A.in[9] + g * 128;
#pragma unroll
        for (int r = 0; r < 16; ++r) { const int p = 32 * rb + att::crow(r, hi); const float b = bs[p]; bf16* up = AB + (size_t)(128 * c + p) * 1024 + 512 + g * 128 + 64 * ch + r32;
#pragma unroll
            for (int dd = 0; dd < 2; ++dd) { const float u = bf2f(up[dd * 32]); up[dd * 32] = (bf16)f2bf(u * (o[dd][r] + b)); } }
    }
}
constexpr int N_PHASES = 18;
__device__ __forceinline__ float* rowss_ptr(unsigned char* ws, int k) { return (float*)(ws + WS_ROWSS) + (size_t)k * M; }

__global__ void __launch_bounds__(NWAVES * 64, 2) mk_fwd(Args args) {
    extern __shared__ __attribute__((aligned(16))) unsigned char lds[];
    Frame F;
    F.lds = (LAS unsigned char*)lds;
    F.tid = threadIdx.x; F.lane = F.tid & 63; F.wave = __builtin_amdgcn_readfirstlane(F.tid >> 6);
    F.G = gridDim.x; { const int bx = blockIdx.x; F.vcu = (F.G % 8 == 0) ? (bx % 8) * (F.G / 8) + bx / 8 : bx; }
    F.out = args.out; F.ws = args.ws;
    unsigned char* ws = args.ws;
    volatile LAS unsigned* MISC = (volatile LAS unsigned*)(F.lds + MISC_OFF);
    for (int u = F.tid; u < (LDS_BYTES - LDSCTL_OFF) / 4; u += NWAVES * 64) ((LAS unsigned*)(F.lds + LDSCTL_OFF))[u] = 0u;
    __syncthreads();
    const int lo = args.ph_lo, hi = args.ph_hi;
    XcdBarrier bar; bar.bar = (unsigned*)(ws + WS_CTL) + CW_BAR + args.li * XCD_BAR_WORDS; bar.x = 0; bar.st = nullptr;
    if (hi - lo > 1) bar = xcd_barrier_post((unsigned*)(ws + WS_CTL) + CW_BAR + args.li * XCD_BAR_WORDS, MISC + 8);

    for (int ph = lo; ph < hi; ++ph) {
        asm volatile("" : "+v"(F.tid), "+v"(F.lane));
        if (!((MK_PHASES >> ph) & 1)) {}
        else if (ph == 0) { p0_prologue(F, args); refresh_rows(F, args.xsrc, rowss_ptr(ws, args.ss_idx)); }
        else if (ph == 1 || ph == 7 || ph == 9 || ph == 15) {
            const int f = ph == 1 ? 0 : (ph == 7 ? 1 : (ph == 9 ? 2 : 3)); const int ssi = ph == 1 ? 0 : (ph == 7 ? 2 : (ph == 9 ? 3 : 5));
            pg8::Gemm g{(const bf16*)(ws + WS_XB), (const bf16*)(ws + WS_WGU) + (size_t)f * NGU * D, M, NGU, D}; pg8::StaticOrder S; S.init(M, NGU, F.G, (int)blockIdx.x);
            pg8::EpiGU E{(bf16*)(ws + WS_ACT), FF, rowss_ptr(ws, ssi), 1.f / D};
            pg8::gemm_phase<pg8::EpiGU, pg8::StaticOrder, true, true>(F.lds, g, S, E);
        }
        else if (ph == 2 || ph == 8 || ph == 10 || ph == 16 || ph == 6 || ph == 14) {
            const bool dn = !(ph == 6 || ph == 14); const int f = ph == 2 ? 0 : (ph == 8 ? 1 : (ph == 10 ? 2 : 3));
            const int sso = ph == 2 ? 1 : (ph == 6 ? 2 : (ph == 8 ? 3 : (ph == 10 ? 4 : (ph == 14 ? 5 : 6))));
            const bf16* A = dn ? (const bf16*)(ws + WS_ACT) : (ph == 6 ? (const bf16*)(ws + WS_AB) : (const bf16*)(ws + WS_QB));
            const bf16* Bt = dn ? (const bf16*)(ws + WS_WD) + (size_t)f * D * FF : (ph == 6 ? (const bf16*)(ws + WS_WOUT) : (const bf16*)(ws + WS_WO));
            pg8::Gemm g{A, Bt, M, D, dn ? FF : D}; pg8::StaticOrder S; S.init(M, D, F.G, (int)blockIdx.x);
            pg8::EpiRes E{(ph == 2 && args.ss_idx == 0) ? args.xsrc : F.out, F.out, (bf16*)(ws + WS_XB), rowss_ptr(ws, sso), dn ? 0.5f : 1.f};
            pg8::gemm_phase<pg8::EpiRes, pg8::StaticOrder, false, true>(F.lds, g, S, E);
        }
        else if (ph == 3 || ph == 11) {
            const bool l0 = ph == 3;
            pg8::Gemm g{(const bf16*)(ws + WS_XB), l0 ? (const bf16*)(ws + WS_WIN) : (const bf16*)(ws + WS_WQKV), M, 1536, D}; pg8::StaticOrder S; S.init(M, 1536, F.G, (int)blockIdx.x);
            pg8::EpiRoute E{(bf16*)(ws + WS_ACT), l0 ? (bf16*)(ws + WS_GV) : (bf16*)(ws + WS_KB), l0 ? (size_t)256 : (size_t)(WS_VB - WS_KB) / 2, l0 ? 512 : 256, l0 ? 2 : 99, rowss_ptr(ws, l0 ? 1 : 4), 1.f / D};
            pg8::gemm_phase<pg8::EpiRoute, pg8::StaticOrder, true, true>(F.lds, g, S, E);
        }
        else if (ph == 4) { fourier1_phase(F); gate_phase(F, args); }
        else if (ph == 5) { fourier2_phase(F); }
        else if (ph == 12) { rope_rows(F, args); }
        else if (ph == 13) {
            const int h = F.vcu >> 5, kvh = h >> 2; int seq = M; asm volatile("" : "+s"(seq));
#pragma unroll 1
            for (int i = 0; i < 2; ++i) { const int qb = 2 * (F.vcu & 31) + i;
                att::bf16* Q = (att::bf16*)(ws + WS_QB) + (size_t)qb * 256 * 1024 + h * 128;
                att::attn_dense_body(Q, (const att::bf16*)(ws + WS_KB) + kvh * 128, (const att::bf16*)(ws + WS_VB) + kvh * 128, Q, seq, (char*)lds); }
        }
        else if (ph == 17) { final_rows(F, rowss_ptr(ws, 6), args.in[19]); }
        if (ph + 1 < hi) xcd_barrier(bar);
    }
}

#ifndef MK_MODE
#define MK_MODE 0
#endif
#ifndef MK_OPT_MASK
#define MK_OPT_MASK 0x7f
#endif
static int mk_grid() {
    static int grid = 0;
    if (grid == 0) {
        int dev = 0, cus = 0, per_cu = 0;
        if (hipGetDevice(&dev) != hipSuccess || hipDeviceGetAttribute(&cus, hipDeviceAttributeMultiprocessorCount, dev) != hipSuccess) { fprintf(stderr, "kernel_launch: device query failed\n"); grid = -1; return grid; }
        if (hipFuncSetAttribute((const void*)mk_fwd, hipFuncAttributeMaxDynamicSharedMemorySize, LDS_BYTES) != hipSuccess) { fprintf(stderr, "kernel_launch: hipFuncSetAttribute failed\n"); grid = -1; return grid; }
        if (hipOccupancyMaxActiveBlocksPerMultiprocessor(&per_cu, (const void*)mk_fwd, NWAVES * 64, LDS_BYTES) != hipSuccess || per_cu < 1) { fprintf(stderr, "kernel_launch: occupancy query says %d blocks per CU\n", per_cu); (void)hipGetLastError(); per_cu = 1; }
        grid = cus;
        if (grid != 256) fprintf(stderr, "kernel_launch: %d CUs (built for 256)\n", grid);
    }
    return grid;
}
static void mk_launch(hipStream_t stream, Args a, int lo, int hi, int li, int grid) {
    a.ph_lo = lo; a.ph_hi = hi; a.li = li;
    if (hi - lo > 1) { void* params[] = {&a}; hipError_t e = hipLaunchCooperativeKernel((const void*)mk_fwd, dim3(grid), dim3(NWAVES * 64), params, LDS_BYTES, stream);
        if (e != hipSuccess) fprintf(stderr, "kernel_launch: cooperative launch failed: %s\n", hipGetErrorString(e)); }
    else { hipLaunchKernelGGL(mk_fwd, dim3(grid), dim3(NWAVES * 64), LDS_BYTES, stream, a);
        const hipError_t le = hipPeekAtLastError(); if (le != hipSuccess) fprintf(stderr, "kernel_launch: launch [%d,%d) failed: %s\n", lo, hi, hipGetErrorName(le)); }
}
extern "C" void kernel_launch(void* const* d_in, const int* in_sizes, int n_in, void* d_out, int out_size, void* d_ws, size_t ws_size, hipStream_t stream) {
    const int grid = mk_grid(); if (grid < 0) return;
    if (n_in != 20 || out_size != M * D || ws_size < WS_END) { fprintf(stderr, "kernel_launch: unexpected shapes (n_in %d out %d ws %zu)\n", n_in, out_size, ws_size); return; }
    Args a{};
    for (int i = 0; i < 20; ++i) a.in[i] = (const float*)d_in[i];
    a.out = (float*)d_out; a.ws = (unsigned char*)d_ws; a.xsrc = (const float*)d_in[0]; a.ss_idx = 0;
#if MK_MODE == 0
    (void)hipMemsetAsync((char*)d_ws + WS_CTL, 0, CTL_ZERO_BYTES, stream);
    mk_launch(stream, a, 0, N_PHASES, 0, grid);
#elif MK_MODE == 1
    (void)hipMemsetAsync((char*)d_ws + WS_CTL, 0, CTL_ZERO_BYTES, stream);
    for (int ph = 0; ph < N_PHASES; ++ph) mk_launch(stream, a, ph, ph + 1, 0, grid);
#else
    nv::setup();
    const float* const* in = (const float* const*)d_in; float* X = (float*)d_out; float* scr = (float*)d_ws; const size_t WFF = (size_t)D * FF;
    (void)hipMemcpyAsync(X, in[0], (size_t)M * D * 4, hipMemcpyDeviceToDevice, stream);
    const int sb_lo[7] = {1, 3, 7, 9, 11, 15, 17}, sb_hi[7] = {3, 7, 9, 11, 15, 17, 18};
    for (int sb = 0; sb < 7; ++sb) {
        if ((MK_OPT_MASK >> sb) & 1) {
            (void)hipMemsetAsync((char*)d_ws + WS_CTL, 0, CTL_ZERO_BYTES, stream);
            Args b = a; b.xsrc = X; b.ss_idx = sb; mk_launch(stream, b, 0, 1, 0, grid);
            for (int ph = sb_lo[sb]; ph < sb_hi[sb]; ++ph) mk_launch(stream, b, ph, ph + 1, 0, grid);
        } else switch (sb) {
            case 0: nv::ffn(stream, X, in[1], in[2], in[3], in[4], scr); break;
            case 1: nv::mix0(stream, X, in[5], in[6], in[7], in[8], in[9], in[10], scr); break;
            case 2: nv::ffn(stream, X, in[15], in[16], in[17], in[18], scr); break;
            case 3: nv::ffn(stream, X, in[1] + 1024, in[2] + WFF, in[3] + WFF, in[4] + WFF, scr); break;
            case 4: nv::mix1(stream, X, in[5] + 1024, in[11], in[12], in[13], in[14], scr); break;
            case 5: nv::ffn(stream, X, in[15] + 1024, in[16] + WFF, in[17] + WFF, in[18] + WFF, scr); break;
            case 6: nv::final_norm(stream, X, in[19]); break; }
    }
#endif
}
```

```cpp
#include <hip/hip_runtime.h>
#include <hip/hip_bf16.h>
#include <cstdio>
#include <cstdint>
#include <cmath>
#define MK_MODE 0
#define MK_OPT_MASK 0x7f
#define MK_REP_PH -1
#define MK_REP_N 0
namespace pg8 {
#define PG8_LAS __attribute__((address_space(3)))
typedef unsigned short bf16_t;
typedef short bf16x8 __attribute__((ext_vector_type(8)));
typedef float f32x4 __attribute__((ext_vector_type(4)));
typedef unsigned u32x4 __attribute__((ext_vector_type(4)));
typedef unsigned u32x2 __attribute__((ext_vector_type(2)));
constexpr int BM = 256, BK = 64, HALF = 128, HTB = HALF * BK * 2  , STAGE_BYTES = 8 * HTB, NXCD = 8, WGM = 8;

__host__ __device__ __forceinline__ int lds_byte(int r, int c) { const int st = (r >> 4) * 2 + (c >> 5), rr = r & 15, cc = c & 31, ob = rr * 64 + cc * 2; return st * 1024 + (ob ^ (((ob >> 9) & 1) << 5)); }
__host__ __device__ __forceinline__ void stage_rc(int b, int& R, int& C) { const int st = b / 1024, sb = b % 1024, swz = sb ^ (((sb >> 9) & 1) << 5); R = (st >> 1) * 16 + swz / 64; C = (st & 1) * 32 + (swz % 64) / 2; }
__host__ __device__ __forceinline__ int perm32(int rho) { const int n = rho >> 4, i = rho & 15; return 8 * (i >> 2) + 4 * n + (i & 3); }

struct Unit { int pm, pn; };
struct Gemm { const bf16_t* A; const bf16_t* Bt; int M, N, K; };

struct StaticOrder {
    int nM, nN, nwg, G, c;
    __host__ __device__ void init(int M, int N, int G_, int c_) { nM = M / BM; nN = N / BM; nwg = nM * nN; G = G_; c = c_; }
    __host__ __device__ bool next(int i, Unit& u) const {
        const long L = (long)i * G + c; if (L >= nwg) return false;
        int wgid = (int)L; { const int q = nwg / NXCD, r = nwg % NXCD, xcd = wgid % NXCD, off = wgid / NXCD; wgid = (xcd < r ? xcd * (q + 1) : r * (q + 1) + (xcd - r) * q) + off; }
        const int nig = WGM * nN, gid = wgid / nig, fm = gid * WGM, gsz = (nM - fm) < WGM ? (nM - fm) : WGM;
        u.pm = fm + ((wgid % nig) % gsz); u.pn = (wgid % nig) / gsz; return true;
    }
    __device__ __forceinline__ void a_ready(const Unit&) const {}
    __device__ __forceinline__ void done(const Unit&) const {}
};

__device__ __forceinline__ float shx(float v, int lane, int o) { return __builtin_bit_cast(float, __builtin_amdgcn_ds_bpermute((lane ^ o) << 2, __builtin_bit_cast(int, v))); }
__device__ __forceinline__ unsigned cvt_pk_bf16(float lo, float hi) { unsigned r; asm volatile("v_cvt_pk_bf16_f32 %0, %1, %2" : "=v"(r) : "v"(lo), "v"(hi)); return r; }
constexpr float RMS_EPS = 1e-6f;
__device__ __forceinline__ float silu_f(float x) { return x * __builtin_amdgcn_rcpf(1.0f + __builtin_amdgcn_exp2f(-1.4426950408889634f * x)); }
__device__ __forceinline__ float gelu_f(float x) { const float t = x * (1.0f + 0.044715f * x * x); return x * __builtin_amdgcn_rcpf(1.0f + __builtin_amdgcn_exp2f(-2.302208198f * t)); }

struct EpiGU {
    static constexpr bool PERM = true, AFTER_DRAIN = false;
    bf16_t* act; int ldc; const float* rowss; float inv_d;
    __device__ __forceinline__ void operator()(const f32x4 (&acc)[2][2][4][2], const Unit& u, int wr, int wc, int fr, int fq) const {
        const int row0 = u.pm * BM + wr * 64 + fr, col0 = u.pn * HALF + wc * 32 + 8 * fq;
#pragma unroll
        for (int ai = 0; ai < 2; ++ai)
#pragma unroll
            for (int m = 0; m < 4; ++m) { const int row = row0 + ai * HALF + m * 16; const float r = __builtin_amdgcn_rsqf(rowss[row] * inv_d + RMS_EPS);
                float o[8];
#pragma unroll
                for (int n = 0; n < 2; ++n)
#pragma unroll
                    for (int e = 0; e < 4; ++e) o[4 * n + e] = silu_f(acc[ai][0][m][n][e] * r) * (acc[ai][1][m][n][e] * r);
                u32x4 w; w.x = cvt_pk_bf16(o[0], o[1]); w.y = cvt_pk_bf16(o[2], o[3]); w.z = cvt_pk_bf16(o[4], o[5]); w.w = cvt_pk_bf16(o[6], o[7]);
                *(u32x4*)(act + (size_t)row * ldc + col0) = w; asm volatile("" ::: "memory"); }
    }
};
struct EpiRes {
    static constexpr bool PERM = false, AFTER_DRAIN = false;
    const float* xin; float* xout; bf16_t* xb; float* ss_out; float alpha; int dry;
    __device__ __forceinline__ void operator()(const f32x4 (&acc)[2][2][4][2], const Unit& u, int wr, int wc, int fr, int fq) const {
        const int row0 = u.pm * BM + wr * 64 + fr, col0 = u.pn * BM + wc * 32 + 4 * fq;
#pragma unroll
        for (int ai = 0; ai < 2; ++ai)
#pragma unroll
            for (int m = 0; m < 4; ++m) { const int row = row0 + ai * HALF + m * 16; const size_t off = (size_t)row * 1024 + col0; float ss = 0.f;
                f32x4 old[2][2];
#pragma unroll
                for (int bj = 0; bj < 2; ++bj)
#pragma unroll
                    for (int n = 0; n < 2; ++n) old[bj][n] = *(const f32x4*)(xin + off + bj * HALF + n * 16);
#pragma unroll
                for (int bj = 0; bj < 2; ++bj)
#pragma unroll
                    for (int n = 0; n < 2; ++n) { const f32x4 v = old[bj][n] + acc[ai][bj][m][n] * alpha; if (!dry) *(f32x4*)(xout + off + bj * HALF + n * 16) = v;
                        u32x2 w; w.x = cvt_pk_bf16(v[0], v[1]); w.y = cvt_pk_bf16(v[2], v[3]); if (!dry) *(u32x2*)(xb + off + bj * HALF + n * 16) = w;
                        ss += (v[0] * v[0] + v[1] * v[1]) + (v[2] * v[2] + v[3] * v[3]); }
                { const int ln = fq * 16 + fr; ss += shx(ss, ln, 16); ss += shx(ss, ln, 32); }
                if (fq == 0 && !dry) atomicAdd(ss_out + row, ss);
                asm volatile("" ::: "memory"); }
    }
};
struct EpiRoute {
    static constexpr bool PERM = true, AFTER_DRAIN = false;
    bf16_t* d0; bf16_t* d1; size_t d12; int ld1; int act_from; const float* rowss; float inv_d;
    __device__ __forceinline__ void operator()(const f32x4 (&acc)[2][2][4][2], const Unit& u, int wr, int wc, int fr, int fq) const {
        const int row0 = u.pm * BM + wr * 64 + fr; const int pn = u.pn;
        bf16_t* base = pn < 4 ? d0 + pn * BM : d1 + (size_t)(pn - 4) * d12; const int ld = pn < 4 ? 1024 : ld1; const bool act = pn >= act_from;
        const int col0 = wc * 32 + 8 * fq;
#pragma unroll
        for (int ai = 0; ai < 2; ++ai)
#pragma unroll
            for (int m = 0; m < 4; ++m) { const int row = row0 + ai * HALF + m * 16; const float r = __builtin_amdgcn_rsqf(rowss[row] * inv_d + RMS_EPS);
                bf16_t* rowp = base + (size_t)row * ld + col0;
#pragma unroll
                for (int bj = 0; bj < 2; ++bj) { float o[8];
#pragma unroll
                    for (int n = 0; n < 2; ++n)
#pragma unroll
                        for (int e = 0; e < 4; ++e) o[4 * n + e] = acc[ai][bj][m][n][e] * r;
                    if (act) {
#pragma unroll
                        for (int e = 0; e < 8; ++e) o[e] = gelu_f(o[e]); }
                    u32x4 w; w.x = cvt_pk_bf16(o[0], o[1]); w.y = cvt_pk_bf16(o[2], o[3]); w.z = cvt_pk_bf16(o[4], o[5]); w.w = cvt_pk_bf16(o[6], o[7]);
                    *(u32x4*)(rowp + bj * HALF) = w; } asm volatile("" ::: "memory"); }
    }
};
template <class Epi, class Sched, bool ALIGN_EPI = false, bool SP2 = false>
__device__ __forceinline__ void gemm_phase(PG8_LAS unsigned char* lds, const Gemm g, const Sched& S, const Epi& E, int tid_) {
    const int tid = tid_, wid = __builtin_amdgcn_readfirstlane(tid >> 6), lane = tid & 63, wr = wid >> 2, wc = wid & 3, fr = lane & 15, fq = lane >> 4;
    const int K = g.K, nt = K / BK;
    unsigned voffA[2], voffB[2];
#pragma unroll
    for (int i = 0; i < 2; ++i) { int R, C; stage_rc(tid * 16 + i * 8192, R, C); const int Rb = Epi::PERM ? ((R & ~31) + perm32(R & 31)) : R;
        voffA[i] = (unsigned)(R * K + C) * 2u; voffB[i] = (unsigned)(Rb * K + C) * 2u; }
    const size_t kstep = (size_t)(BK * 2);
    const size_t hstep = (size_t)HALF * K * 2;
    const size_t tstep = 2 * hstep;
    const unsigned ldsw = (unsigned)wid * 1024u;
    const int aoff = lds_byte(wr * 64 + fr, fq * 8), boff = lds_byte(wc * 32 + fr, fq * 8);
#define PG8_SA(b, h) (((b) * 2 + (h)) * HTB)
#define PG8_SB(b, h) ((4 + (b) * 2 + (h)) * HTB)
#define PG8_STAGE(bufoff, gbase, voff) do { _Pragma("unroll") for (int _i = 0; _i < 2; ++_i) \
        __builtin_amdgcn_global_load_lds((const unsigned*)((const char*)(gbase) + (voff)[_i]), (PG8_LAS unsigned*)(lds + (bufoff) + ldsw + _i * 8192), 16, 0, 0); } while (0)
#define PG8_LDA(dst, b, h) do { _Pragma("unroll") for (int m = 0; m < 4; ++m) _Pragma("unroll") for (int k = 0; k < 2; ++k) dst[m][k] = *(const PG8_LAS bf16x8*)(lds + PG8_SA(b, h) + aoff + m * 2048 + k * 1024); } while (0)
#define PG8_LDB(dst, b, h) do { _Pragma("unroll") for (int n = 0; n < 2; ++n) _Pragma("unroll") for (int k = 0; k < 2; ++k) dst[n][k] = *(const PG8_LAS bf16x8*)(lds + PG8_SB(b, h) + boff + n * 2048 + k * 1024); } while (0)
#define PG8_MMA(ai, bj, At, Bt) do { __builtin_amdgcn_s_setprio(1); _Pragma("unroll") for (int m = 0; m < 4; ++m) _Pragma("unroll") for (int n = 0; n < 2; ++n) _Pragma("unroll") for (int k = 0; k < 2; ++k) \
        acc[ai][bj][m][n] = __builtin_amdgcn_mfma_f32_16x16x32_bf16(Bt[n][k], At[m][k], acc[ai][bj][m][n], 0, 0, 0); __builtin_amdgcn_s_setprio(0); } while (0)
#define PG8_WAIT_V(n) asm volatile("s_waitcnt vmcnt(" #n ")" ::: "memory")
#define PG8_WAIT_L(n) asm volatile("s_waitcnt lgkmcnt(" #n ")" ::: "memory")
#define PG8_BAR __builtin_amdgcn_s_barrier()
#define PG8_SCHED __builtin_amdgcn_sched_barrier(0)
    Unit cur, nxt; int ui = 0;
    if (!S.next(0, cur)) return;
    f32x4 acc[2][2][4][2];
#pragma unroll
    for (int a = 0; a < 2; ++a)
#pragma unroll
        for (int b = 0; b < 2; ++b)
#pragma unroll
            for (int m = 0; m < 4; ++m)
#pragma unroll
                for (int n = 0; n < 2; ++n) acc[a][b][m][n] = (f32x4){0.f, 0.f, 0.f, 0.f};
    bf16x8 At[4][2], B0[2][2], B1[2][2];
    const char* cA = (const char*)g.A + (size_t)cur.pm * tstep; const char* cB = (const char*)g.Bt + (size_t)cur.pn * tstep;
    S.a_ready(cur);
    if constexpr (SP2) {
        PG8_STAGE(PG8_SB(0, 0), cB, voffB); PG8_STAGE(PG8_SB(0, 1), cB + hstep, voffB); PG8_STAGE(PG8_SA(0, 0), cA, voffA); PG8_STAGE(PG8_SA(0, 1), cA + hstep, voffA);
        if (wr == 1) PG8_BAR;
        PG8_WAIT_V(2); PG8_BAR;
        PG8_STAGE(PG8_SB(1, 0), cB + kstep, voffB); PG8_STAGE(PG8_SA(1, 0), cA + kstep, voffA); PG8_STAGE(PG8_SB(1, 1), cB + hstep + kstep, voffB);
        PG8_WAIT_V(6); PG8_BAR;
    } else {
        PG8_STAGE(PG8_SB(0, 0), cB, voffB); PG8_STAGE(PG8_SA(0, 0), cA, voffA); PG8_STAGE(PG8_SB(0, 1), cB + hstep, voffB); PG8_STAGE(PG8_SA(0, 1), cA + hstep, voffA);
        if (wr == 1) PG8_BAR;
        PG8_WAIT_V(4); PG8_BAR;
        PG8_STAGE(PG8_SB(1, 0), cB + kstep, voffB); PG8_STAGE(PG8_SA(1, 0), cA + kstep, voffA); PG8_STAGE(PG8_SB(1, 1), cB + hstep + kstep, voffB);
        PG8_WAIT_V(6); PG8_BAR;
    }
    for (;;) {
        const bool has_next = S.next(ui + 1, nxt);
        const char* nA = has_next ? (const char*)g.A + (size_t)nxt.pm * tstep : cA; const char* nB = has_next ? (const char*)g.Bt + (size_t)nxt.pn * tstep : cB;
        for (int t = 0; t < nt; t += 2) {
            const bool last = (t == nt - 2);
            const char* a1 = cA + (size_t)(t + 1) * kstep;
            const char* a2 = last ? nA : cA + (size_t)(t + 2) * kstep; const char* b2 = last ? nB : cB + (size_t)(t + 2) * kstep;
            const char* a3 = a2 + kstep; const char* b3 = b2 + kstep;
            if (last && has_next) S.a_ready(nxt);
            if constexpr (SP2) {
            PG8_LDB(B0, 0, 0); PG8_LDB(B1, 0, 1); PG8_SCHED; PG8_LDA(At, 0, 0); PG8_STAGE(PG8_SA(1, 1), a1 + hstep, voffA);
            PG8_WAIT_V(8); PG8_WAIT_L(0); PG8_BAR; PG8_MMA(0, 0, At, B0); PG8_MMA(0, 1, At, B1); PG8_BAR; PG8_SCHED;
            PG8_LDA(At, 0, 1); PG8_STAGE(PG8_SB(0, 0), b2, voffB); PG8_STAGE(PG8_SB(0, 1), b2 + hstep, voffB); PG8_STAGE(PG8_SA(0, 0), a2, voffA);
            PG8_WAIT_V(8); PG8_WAIT_L(0); PG8_BAR; PG8_MMA(1, 0, At, B0); PG8_MMA(1, 1, At, B1); PG8_BAR; PG8_SCHED;
            PG8_LDB(B0, 1, 0); PG8_LDB(B1, 1, 1); PG8_SCHED; PG8_LDA(At, 1, 0); PG8_STAGE(PG8_SA(0, 1), a2 + hstep, voffA);
            PG8_WAIT_V(8); PG8_WAIT_L(0); PG8_BAR; PG8_MMA(0, 0, At, B0); PG8_MMA(0, 1, At, B1); PG8_BAR; PG8_SCHED;
            PG8_LDA(At, 1, 1); PG8_STAGE(PG8_SB(1, 0), b3, voffB); PG8_STAGE(PG8_SB(1, 1), b3 + hstep, voffB); PG8_STAGE(PG8_SA(1, 0), a3, voffA);
            PG8_WAIT_V(8); PG8_WAIT_L(0); PG8_BAR; PG8_MMA(1, 0, At, B0); PG8_MMA(1, 1, At, B1); PG8_BAR; PG8_SCHED;
            } else {
            PG8_LDB(B0, 0, 0); PG8_SCHED; PG8_LDA(At, 0, 0); PG8_STAGE(PG8_SA(1, 1), a1 + hstep, voffA);
            PG8_WAIT_L(8); PG8_BAR; PG8_WAIT_L(0); PG8_MMA(0, 0, At, B0); PG8_BAR; PG8_SCHED;
            PG8_LDB(B1, 0, 1); PG8_STAGE(PG8_SB(0, 0), b2, voffB);
            PG8_BAR; PG8_WAIT_L(0); PG8_MMA(0, 1, At, B1); PG8_BAR;
            PG8_LDA(At, 0, 1); PG8_STAGE(PG8_SA(0, 0), a2, voffA);
            PG8_BAR; PG8_WAIT_L(0); PG8_MMA(1, 0, At, B0); PG8_BAR; PG8_SCHED;
            PG8_STAGE(PG8_SB(0, 1), b2 + hstep, voffB);
            PG8_WAIT_V(6); PG8_BAR; PG8_MMA(1, 1, At, B1); PG8_BAR;
            PG8_LDB(B0, 1, 0); PG8_SCHED; PG8_LDA(At, 1, 0); PG8_STAGE(PG8_SA(0, 1), a2 + hstep, voffA);
            PG8_WAIT_L(8); PG8_BAR; PG8_WAIT_L(0); PG8_MMA(0, 0, At, B0); PG8_BAR; PG8_SCHED;
            PG8_LDB(B1, 1, 1); PG8_STAGE(PG8_SB(1, 0), b3, voffB);
            PG8_BAR; PG8_WAIT_L(0); PG8_MMA(0, 1, At, B1); PG8_BAR;
            PG8_LDA(At, 1, 1); PG8_STAGE(PG8_SA(1, 0), a3, voffA);
            PG8_BAR; PG8_WAIT_L(0); PG8_MMA(1, 0, At, B0); PG8_BAR; PG8_SCHED;
            PG8_STAGE(PG8_SB(1, 1), b3 + hstep, voffB);
            PG8_WAIT_V(6); PG8_BAR; PG8_MMA(1, 1, At, B1); PG8_BAR;
            }
        }
        if constexpr (ALIGN_EPI) { if (wr == 0) PG8_BAR; }
        if constexpr (!Epi::AFTER_DRAIN) { E(acc, cur, wr, wc, fr, fq); S.done(cur); }
        if (!has_next) break;
#pragma unroll
        for (int a = 0; a < 2; ++a)
#pragma unroll
            for (int b = 0; b < 2; ++b)
#pragma unroll
                for (int m = 0; m < 4; ++m)
#pragma unroll
                    for (int n = 0; n < 2; ++n) acc[a][b][m][n] = (f32x4){0.f, 0.f, 0.f, 0.f};
        cur = nxt; cA = nA; cB = nB; ++ui;
        if constexpr (ALIGN_EPI) { if (wr == 1) PG8_BAR; }
    }
    PG8_WAIT_V(0);
    if constexpr (!ALIGN_EPI) { if (wr == 0) PG8_BAR; }
    PG8_BAR;
    if constexpr (Epi::AFTER_DRAIN) { E.fused(acc, cur, wr, wc, fr, fq, lds, wid, lane); S.done(cur); }
#undef PG8_SA
#undef PG8_SB
#undef PG8_STAGE
#undef PG8_LDA
#undef PG8_LDB
#undef PG8_MMA
#undef PG8_WAIT_V
#undef PG8_WAIT_L
#undef PG8_BAR
#undef PG8_SCHED
}
}
namespace att {
using bf16 = __hip_bfloat16;
constexpr int   D = 128, NW = 8, QBLK = 32, KVBLK = 64;
constexpr float SCALE = 0.088388347648318440f;
constexpr float THR = 8.f;
#ifndef ATT_SDEPTH
#define ATT_SDEPTH 2
#endif
constexpr int SDEPTH = ATT_SDEPTH;
constexpr int LDQ = 1024, LDK = 256, LDO = 1024;
constexpr size_t SHM_V = KVBLK * D * 2, SHM_K = KVBLK * D * 2, SHM_ATTN = 2 * SHM_V + 2 * SHM_K + NW * 64 * 4;

using bf16x8 = __attribute__((ext_vector_type(8))) short;
using s16x4  = __attribute__((ext_vector_type(4))) short;
using f32x16 = __attribute__((ext_vector_type(16))) float;
using u32x4  = __attribute__((ext_vector_type(4))) unsigned;
#define KSWZ(row, colB) ((row) * 256 + ((colB) ^ (((row) & 7) << 4)))
#define KSWZ16(row, colB) ((row) * 256 + ((colB) ^ (((row) & 15) << 4)))
#define SBAR() __builtin_amdgcn_sched_barrier(0)
__device__ __forceinline__ int crow(int r, int hi) { return (r & 3) + 8 * (r >> 2) + 4 * hi; }
__device__ __forceinline__ unsigned cvtpk(float lo, float hi) { unsigned r; asm volatile("v_cvt_pk_bf16_f32 %0, %1, %2" : "=v"(r) : "v"(lo), "v"(hi)); return r; }
__device__ __forceinline__ unsigned short f2bf(float f) { return (unsigned short)(cvtpk(f, 0.f) & 0xffffu); }
__device__ __forceinline__ float bf2f(unsigned short h) { return __uint_as_float((unsigned)h << 16); }

constexpr float THRL = 8.f * 1.4426950408889634f;
__device__ __forceinline__ void partialSM_s(f32x16& p0, f32x16& p1, float& m_reg, float& mn, float& alpha) {
  float pmax = p0[0]; for (int r = 1; r < 16; ++r) pmax = fmaxf(pmax, p0[r]); for (int r = 0; r < 16; ++r) pmax = fmaxf(pmax, p1[r]);
  { auto rr = __builtin_amdgcn_permlane32_swap(__float_as_uint(pmax), __float_as_uint(pmax), false, false);
    pmax = fmaxf(__uint_as_float(rr[0]), __uint_as_float(rr[1])); }
  if (__builtin_expect(__all(pmax - m_reg <= THRL), 1)) { mn = m_reg; alpha = 1.f; }
  else { mn = fmaxf(m_reg, pmax); alpha = __builtin_amdgcn_exp2f(m_reg - mn); m_reg = mn; }
  for (int r = 0; r < 16; ++r) p0[r] -= mn; for (int r = 0; r < 16; ++r) p1[r] -= mn;
  for (int r = 0; r < 16; ++r) p0[r] = __builtin_amdgcn_exp2f(p0[r]);
}
__device__ __forceinline__ void finishSM_s(f32x16& p0, f32x16& p1, float alpha, float& l_reg, bf16x8& pa0, bf16x8& pa1, bf16x8& pa2, bf16x8& pa3) {
  for (int r = 0; r < 16; ++r) p1[r] = __builtin_amdgcn_exp2f(p1[r]);
  float ps = 0; for (int r = 0; r < 16; ++r) ps += p0[r]; for (int r = 0; r < 16; ++r) ps += p1[r];
  { auto rr = __builtin_amdgcn_permlane32_swap(__float_as_uint(ps), __float_as_uint(ps), false, false);
    ps = __uint_as_float(rr[0]) + __uint_as_float(rr[1]); }
  l_reg = l_reg * alpha + ps;
#define PK4(P, BASE, OUT) do { unsigned a0 = cvtpk(P[BASE + 0], P[BASE + 1]), a1 = cvtpk(P[BASE + 2], P[BASE + 3]);   \
    unsigned b0 = cvtpk(P[BASE + 4], P[BASE + 5]), b1 = cvtpk(P[BASE + 6], P[BASE + 7]);                              \
    auto r0 = __builtin_amdgcn_permlane32_swap(a0, b0, false, false); auto r1 = __builtin_amdgcn_permlane32_swap(a1, b1, false, false); \
    u32x4 w = {r0[0], r1[0], r0[1], r1[1]}; OUT = *reinterpret_cast<bf16x8*>(&w); } while (0)
  PK4(p0, 0, pa0); PK4(p0, 8, pa1); PK4(p1, 0, pa2); PK4(p1, 8, pa3);
#undef PK4
}
__device__ __forceinline__ void partialSM(f32x16& p0) { for (int r = 0; r < 16; ++r) p0[r] = __builtin_amdgcn_exp2f(p0[r]); }
__device__ __forceinline__ void finishSM(f32x16& p0, f32x16& p1, float& l_reg, bf16x8& pa0, bf16x8& pa1, bf16x8& pa2, bf16x8& pa3) {
  for (int r = 0; r < 16; ++r) p1[r] = __builtin_amdgcn_exp2f(p1[r]);
  float ps = 0; for (int r = 0; r < 16; ++r) ps += p0[r]; for (int r = 0; r < 16; ++r) ps += p1[r];
  l_reg += ps;
#define PK4(P, BASE, OUT) do { unsigned a0 = cvtpk(P[BASE + 0], P[BASE + 1]), a1 = cvtpk(P[BASE + 2], P[BASE + 3]);   \
    unsigned b0 = cvtpk(P[BASE + 4], P[BASE + 5]), b1 = cvtpk(P[BASE + 6], P[BASE + 7]);                              \
    auto r0 = __builtin_amdgcn_permlane32_swap(a0, b0, false, false); auto r1 = __builtin_amdgcn_permlane32_swap(a1, b1, false, false); \
    u32x4 w = {r0[0], r1[0], r0[1], r1[1]}; OUT = *reinterpret_cast<bf16x8*>(&w); } while (0)
  PK4(p0, 0, pa0); PK4(p0, 8, pa1); PK4(p1, 0, pa2); PK4(p1, 8, pa3);
#undef PK4
}
__device__ __forceinline__ void qkt(f32x16& p0, f32x16& p1, const bf16* Ks, const bf16x8* qr, int r32, int hi) {
  p0 = f32x16{}; p1 = f32x16{};
  for (int d0 = 0; d0 < 8; ++d0) { int cb = (d0 * 16 + hi * 8) * 2;
    bf16x8 b0 = *reinterpret_cast<const bf16x8*>((const char*)Ks + KSWZ(r32, cb));
    bf16x8 b1 = *reinterpret_cast<const bf16x8*>((const char*)Ks + KSWZ(32 + r32, cb));
    p0 = __builtin_amdgcn_mfma_f32_32x32x16_bf16(b0, qr[d0], p0, 0, 0, 0);
    p1 = __builtin_amdgcn_mfma_f32_32x32x16_bf16(b1, qr[d0], p1, 0, 0, 0);
    if (d0 & 1) asm volatile("" ::: "memory"); }
}
__device__ __forceinline__ int v_st(int k, int c) { const int kk = (k & ~0xC) | ((k & 4) << 1) | ((k & 8) >> 1); return ((kk >> 3) * 4 + (c >> 5)) * 512 + ((kk & 7) * 32 + (c & 31)) * 2; }
__device__ __forceinline__ int v_rd_base(int lane) { return ((lane & 3) << 3) | (((lane >> 2) & 3) << 6) | (((lane >> 4) & 1) << 5) | (((lane >> 5) & 1) << 8); }
constexpr int v_rd_off(int d0, int ks, int half) { return d0 * 512 + ks * 4096 + half * 2048; }
template <int OFF> __device__ __forceinline__ s16x4 tr_read(int vb) {
  s16x4 r; asm volatile("ds_read_b64_tr_b16 %0, %1 offset:%2" : "=&v"(r) : "v"(vb), "i"(OFF) : "memory"); return r;
}
template <int D0> __device__ __forceinline__ void pv_one(f32x16& od, int vb, bf16x8 pa0, bf16x8 pa1, bf16x8 pa2, bf16x8 pa3) {
  const s16x4 l0 = tr_read<v_rd_off(D0, 0, 0)>(vb), h0 = tr_read<v_rd_off(D0, 0, 1)>(vb), l1 = tr_read<v_rd_off(D0, 1, 0)>(vb), h1 = tr_read<v_rd_off(D0, 1, 1)>(vb);
  const s16x4 l2 = tr_read<v_rd_off(D0, 2, 0)>(vb), h2 = tr_read<v_rd_off(D0, 2, 1)>(vb), l3 = tr_read<v_rd_off(D0, 3, 0)>(vb), h3 = tr_read<v_rd_off(D0, 3, 1)>(vb);
  asm volatile("s_waitcnt lgkmcnt(0)" ::: "memory"); SBAR();
#define PK(L, H) (bf16x8){L[0], L[1], L[2], L[3], H[0], H[1], H[2], H[3]}
  od = __builtin_amdgcn_mfma_f32_32x32x16_bf16(pa0, PK(l0, h0), od, 0, 0, 0);
  od = __builtin_amdgcn_mfma_f32_32x32x16_bf16(pa1, PK(l1, h1), od, 0, 0, 0);
  od = __builtin_amdgcn_mfma_f32_32x32x16_bf16(pa2, PK(l2, h2), od, 0, 0, 0);
  od = __builtin_amdgcn_mfma_f32_32x32x16_bf16(pa3, PK(l3, h3), od, 0, 0, 0);
#undef PK
}
__device__ __forceinline__ void pv_d0(f32x16* o, int vb, bf16x8 pa0, bf16x8 pa1, bf16x8 pa2, bf16x8 pa3) {
  pv_one<0>(o[0], vb, pa0, pa1, pa2, pa3); pv_one<1>(o[1], vb, pa0, pa1, pa2, pa3); pv_one<2>(o[2], vb, pa0, pa1, pa2, pa3); pv_one<3>(o[3], vb, pa0, pa1, pa2, pa3);
}

constexpr int ST_K = 0, ST_V = 3 * (int)SHM_K, ST_WS = ST_V + 4 * (int)SHM_V, ST_BYTES = ST_WS + NW * 64 * 4;
#define ABAR() do { asm volatile("s_waitcnt lgkmcnt(0)" ::: "memory"); __builtin_amdgcn_s_barrier(); asm volatile("" ::: "memory"); } while (0)
template <bool SAFE, int ABL = 0>
__device__ __forceinline__ void attn_stag_body(const bf16* Qb, const bf16* __restrict__ Kh, const bf16* __restrict__ Vh, bf16* Ob, int seq, char* lds, int tid_) {
  const int tid = tid_, wid = __builtin_amdgcn_readfirstlane(tid >> 6), lane = tid & 63, r32 = lane & 31, hi = lane >> 5, half = wid >> 2;
  char* K_lds = lds + ST_K; char* V_lds = lds + ST_V;
  float* ws = (float*)(lds + ST_WS) + wid * 64; float* li_l = ws; float* al_l = ws + 32;
  float m_reg = -1e30f, l_reg = 0; f32x16 o[4] = {}; bf16x8 qr[8];
  const bf16* Qw = Qb + (long)(wid * QBLK + r32) * LDQ + hi * 8;
#pragma unroll
  for (int d0 = 0; d0 < 8; ++d0) qr[d0] = *reinterpret_cast<const bf16x8*>(Qw + d0 * 16);
  const int wl = wid & 3, c0 = 8 * half + 2 * wl;
  int offK0, offK1, offV0, offV1;
  { const int r0 = 4 * c0 + (lane >> 4), r1 = r0 + 4, sl = lane & 15; offK0 = r0 * LDK + ((sl ^ (r0 & 15)) << 3); offK1 = r1 * LDK + ((sl ^ (r1 & 15)) << 3);
    const int st0 = 2 * c0 + (lane >> 5), st1 = st0 + 2; const int kk0 = ((st0 >> 2) << 3) | ((lane >> 2) & 7), kk1 = ((st1 >> 2) << 3) | ((lane >> 2) & 7);
    const int k0 = (kk0 & ~0xC) | ((kk0 & 4) << 1) | ((kk0 & 8) >> 1), k1 = (kk1 & ~0xC) | ((kk1 & 4) << 1) | ((kk1 & 8) >> 1);
    offV0 = k0 * LDK + (st0 & 3) * 32 + (lane & 3) * 8; offV1 = k1 * LDK + (st1 & 3) * 32 + (lane & 3) * 8; }
  const int vb0 = (int)(uintptr_t)V_lds + v_rd_base(lane);
  typedef __attribute__((address_space(3))) unsigned* ldsu_t;
  const __amdgpu_buffer_rsrc_t rsK = __builtin_amdgcn_make_buffer_rsrc((void*)Kh, 0, 16384 * LDK * 2, 0x00020000), rsV = __builtin_amdgcn_make_buffer_rsrc((void*)Vh, 0, 16384 * LDK * 2, 0x00020000);
  offK0 *= 2; offK1 *= 2; offV0 *= 2; offV1 *= 2;
#define SDMA(t) do { const int so_ = (t) * (KVBLK * LDK * 2); \
    char* kd_ = K_lds + ((t) % 3) * SHM_K + c0 * 1024; char* vd_ = V_lds + ((t) & 3) * SHM_V + c0 * 1024; \
    __builtin_amdgcn_raw_ptr_buffer_load_lds(rsK, (ldsu_t)(uintptr_t)kd_, 16, offK0, so_, 0, 0); __builtin_amdgcn_raw_ptr_buffer_load_lds(rsK, (ldsu_t)(uintptr_t)(kd_ + 1024), 16, offK1, so_, 0, 0); \
    __builtin_amdgcn_raw_ptr_buffer_load_lds(rsV, (ldsu_t)(uintptr_t)vd_, 16, offV0, so_, 0, 0); __builtin_amdgcn_raw_ptr_buffer_load_lds(rsV, (ldsu_t)(uintptr_t)(vd_ + 1024), 16, offV1, so_, 0, 0); } while (0)
#define SDMA_WAIT() asm volatile("s_waitcnt vmcnt(0)" ::: "memory")
  const int NT = seq / KVBLK;
  f32x16 p0, p1; bf16x8 pa0, pa1, pa2, pa3;
#define TR8(S, VB, D0) do { if constexpr (ABL == 3) { asm volatile("" : "=v"(S##l0), "=v"(S##h0), "=v"(S##l1), "=v"(S##h1), "=v"(S##l2), "=v"(S##h2), "=v"(S##l3), "=v"(S##h3)); break; } \
    S##l0 = tr_read<v_rd_off(D0, 0, 0)>(VB); S##h0 = tr_read<v_rd_off(D0, 0, 1)>(VB); S##l1 = tr_read<v_rd_off(D0, 1, 0)>(VB); S##h1 = tr_read<v_rd_off(D0, 1, 1)>(VB); \
    S##l2 = tr_read<v_rd_off(D0, 2, 0)>(VB); S##h2 = tr_read<v_rd_off(D0, 2, 1)>(VB); S##l3 = tr_read<v_rd_off(D0, 3, 0)>(VB); S##h3 = tr_read<v_rd_off(D0, 3, 1)>(VB); } while (0)
#define PKV(L, H) (bf16x8){L[0], L[1], L[2], L[3], H[0], H[1], H[2], H[3]}
#define MFMA4(OD, S) do { if constexpr (ABL == 2) { asm volatile("" :: "v"(S##l0), "v"(S##h0), "v"(S##l1), "v"(S##h1), "v"(S##l2), "v"(S##h2), "v"(S##l3), "v"(S##h3)); break; } \
    OD = __builtin_amdgcn_mfma_f32_32x32x16_bf16(pa0, PKV(S##l0, S##h0), OD, 0, 0, 0); OD = __builtin_amdgcn_mfma_f32_32x32x16_bf16(pa1, PKV(S##l1, S##h1), OD, 0, 0, 0); \
    OD = __builtin_amdgcn_mfma_f32_32x32x16_bf16(pa2, PKV(S##l2, S##h2), OD, 0, 0, 0); OD = __builtin_amdgcn_mfma_f32_32x32x16_bf16(pa3, PKV(S##l3, S##h3), OD, 0, 0, 0); } while (0)
#define LWAIT(N) do { asm volatile("s_waitcnt lgkmcnt(" #N ")" ::: "memory"); SBAR(); } while (0)
  const int kx = (hi << 4) ^ ((r32 & 15) << 4);
  typedef __attribute__((address_space(3))) const bf16x8* lk_t;
#define KRD(B0, B1, KB, D0) do { if constexpr (ABL == 3) { asm volatile("" : "=v"(B0), "=v"(B1)); break; } const int a_ = (KB) + r32 * 256 + (((D0) << 5) ^ kx); B0 = *(lk_t)(uintptr_t)a_; B1 = *(lk_t)(uintptr_t)(a_ + 8192); } while (0)
#define QM(D, B0, B1) do { if constexpr (ABL == 2) { asm volatile("" :: "v"(B0), "v"(B1)); } else { p0 = __builtin_amdgcn_mfma_f32_32x32x16_bf16(B0, qr[D], p0, 0, 0, 0); p1 = __builtin_amdgcn_mfma_f32_32x32x16_bf16(B1, qr[D], p1, 0, 0, 0); } } while (0)
#define QK8() do { p0 = f32x16{}; p1 = f32x16{}; \
    KRD(k20, k21, kb, 2); SBAR(); LWAIT(4); QM(0, k00, k01); SBAR(); KRD(k00, k01, kb, 3); SBAR(); LWAIT(4); QM(1, k10, k11); SBAR(); KRD(k10, k11, kb, 4); SBAR(); LWAIT(4); QM(2, k20, k21); SBAR(); \
    KRD(k20, k21, kb, 5); SBAR(); LWAIT(4); QM(3, k00, k01); SBAR(); KRD(k00, k01, kb, 6); SBAR(); LWAIT(4); QM(4, k10, k11); SBAR(); KRD(k10, k11, kb, 7); SBAR(); LWAIT(4); QM(5, k20, k21); SBAR(); \
    LWAIT(2); QM(6, k00, k01); SBAR(); LWAIT(0); QM(7, k10, k11); SBAR(); } while (0)
  SDMA(0); if (half) SDMA(1);
  SDMA_WAIT(); ABAR();
  if (half) SDMA(2); else SDMA(1);
  if (half) ABAR();
  {
    const int kb = (int)(uintptr_t)K_lds; bf16x8 k00, k01, k10, k11, k20, k21;
    __builtin_amdgcn_s_setprio(1);
    KRD(k00, k01, kb, 0); KRD(k10, k11, kb, 1); SBAR();
    QK8();
    __builtin_amdgcn_s_setprio(0);
    ABAR();
  }
  for (int i = 0; i < NT; ++i) {
    const int vb = vb0 + (i & 3) * (int)SHM_V;
    s16x4 vAl0, vAl1, vAl2, vAl3, vAh0, vAh1, vAh2, vAh3, vBl0, vBl1, vBl2, vBl3, vBh0, vBh1, vBh2, vBh3;
    TR8(vA, vb, 0); TR8(vB, vb, 1); SBAR();
    if constexpr (ABL != 4) { const int tw = i + 1 + half;
      SDMA_WAIT(); if (tw + 1 < NT) SDMA(tw + 1); }
    SBAR();
    if constexpr (SAFE) {
      float pmax = p0[0]; for (int r = 1; r < 16; ++r) pmax = fmaxf(pmax, p0[r]); for (int r = 0; r < 16; ++r) pmax = fmaxf(pmax, p1[r]);
      { auto rr = __builtin_amdgcn_permlane32_swap(__float_as_uint(pmax), __float_as_uint(pmax), false, false); pmax = fmaxf(__uint_as_float(rr[0]), __uint_as_float(rr[1])); }
      if (!__all(pmax - m_reg <= THRL)) { const float mn = fmaxf(m_reg, pmax), alpha = __builtin_amdgcn_exp2f(m_reg - mn); m_reg = mn; l_reg *= alpha;
        if (hi == 0) al_l[r32] = alpha; asm volatile("s_waitcnt lgkmcnt(0)" ::: "memory");
        for (int d = 0; d < 4; ++d) for (int r = 0; r < 16; ++r) o[d][r] *= al_l[crow(r, hi)]; }
      for (int r = 0; r < 16; ++r) p0[r] -= m_reg; for (int r = 0; r < 16; ++r) p1[r] -= m_reg;
    }
    if constexpr (ABL != 1) { for (int r = 0; r < 16; ++r) p0[r] = __builtin_amdgcn_exp2f(p0[r]); for (int r = 0; r < 16; ++r) p1[r] = __builtin_amdgcn_exp2f(p1[r]);
      float s0 = p0[0] + p1[0], s1 = p0[1] + p1[1], s2 = p0[2] + p1[2], s3 = p0[3] + p1[3];
      for (int r = 4; r < 16; r += 4) { s0 += p0[r] + p1[r]; s1 += p0[r + 1] + p1[r + 1]; s2 += p0[r + 2] + p1[r + 2]; s3 += p0[r + 3] + p1[r + 3]; }
      l_reg += (s0 + s1) + (s2 + s3); }
#define PK4(P, BASE, OUT) do { unsigned a0 = cvtpk(P[BASE + 0], P[BASE + 1]), a1 = cvtpk(P[BASE + 2], P[BASE + 3]);   \
    unsigned b0 = cvtpk(P[BASE + 4], P[BASE + 5]), b1 = cvtpk(P[BASE + 6], P[BASE + 7]);                              \
    auto r0 = __builtin_amdgcn_permlane32_swap(a0, b0, false, false); auto r1 = __builtin_amdgcn_permlane32_swap(a1, b1, false, false); \
    u32x4 w = {r0[0], r1[0], r0[1], r1[1]}; OUT = *reinterpret_cast<bf16x8*>(&w); } while (0)
    if constexpr (ABL != 1) { PK4(p0, 0, pa0); PK4(p0, 8, pa1); PK4(p1, 0, pa2); PK4(p1, 8, pa3); }
    else { asm volatile("" : "=v"(pa0), "=v"(pa1), "=v"(pa2), "=v"(pa3) : "v"(p0), "v"(p1)); }
#undef PK4
    ABAR();
    const int kb = (int)(uintptr_t)K_lds + ((i + 1) % 3) * (int)SHM_K; const bool more = i + 1 < NT;
    bf16x8 k00, k01, k10, k11, k20, k21;
    __builtin_amdgcn_s_setprio(1);
    MFMA4(o[0], vA); SBAR(); TR8(vA, vb, 2); SBAR();
    MFMA4(o[1], vB); SBAR(); TR8(vB, vb, 3); SBAR();
    LWAIT(8); MFMA4(o[2], vA); SBAR(); if (more) { KRD(k00, k01, kb, 0); } SBAR();
    if (more) { LWAIT(2); } else { LWAIT(0); }
    MFMA4(o[3], vB); SBAR(); if (more) { KRD(k10, k11, kb, 1); SBAR(); QK8(); }
    __builtin_amdgcn_s_setprio(0);
    if (more) ABAR();
  }
  if (!half) ABAR();
  { auto rr = __builtin_amdgcn_permlane32_swap(__float_as_uint(l_reg), __float_as_uint(l_reg), false, false); l_reg = __uint_as_float(rr[0]) + __uint_as_float(rr[1]); }
  if (hi == 0) li_l[r32] = l_reg; asm volatile("s_waitcnt lgkmcnt(0)" ::: "memory");
  float rli[16];
#pragma unroll
  for (int r = 0; r < 16; ++r) rli[r] = __builtin_amdgcn_rcpf(li_l[crow(r, hi)]);
  unsigned short* Ow = (unsigned short*)Ob + (long)(wid * QBLK) * LDO;
#pragma unroll
  for (int r = 0; r < 16; ++r) { int orow = crow(r, hi);
    for (int d0 = 0; d0 < 4; ++d0) Ow[(long)orow * LDO + d0 * 32 + r32] = f2bf(o[d0][r] * rli[r]); }
  __syncthreads();
#undef SDMA
#undef SDMA_WAIT
#undef TR8
#undef PKV
#undef MFMA4
#undef QM
#undef QK8
#undef LWAIT
#undef KRD
}
#undef ABAR
}
constexpr int NWAVES = 8;
constexpr int M = 16384, D = 1024, FF = 2816, NGU = 2 * FF, NIN = 1536, NQKV = 1536;
constexpr size_t MiB = 1u << 20;
constexpr size_t WS_CTL = 0, CTL_ZERO_BYTES = 1 * MiB;
constexpr size_t WS_ROWSS = 128 * 1024;
constexpr size_t WS_TAB = 1 * MiB;
constexpr size_t TAB_ROPE = WS_TAB;
constexpr size_t TAB_TW = WS_TAB + 96 * 1024;
constexpr size_t TAB_P1 = WS_TAB + 224 * 1024;
constexpr size_t TAB_P2 = WS_TAB + 288 * 1024;
constexpr size_t TAB_WS = WS_TAB + 416 * 1024;
constexpr size_t WS_WGU = 2 * MiB;
constexpr size_t WS_WD = WS_WGU + 44 * MiB;
constexpr size_t WS_WIN = WS_WD + 22 * MiB;
constexpr size_t WS_WOUT = WS_WIN + 3 * MiB;
constexpr size_t WS_WQKV = WS_WOUT + 2 * MiB;
constexpr size_t WS_WO = WS_WQKV + 3 * MiB;
constexpr size_t WS_XB = WS_WO + 2 * MiB;
constexpr size_t WS_ACT = WS_XB + 32 * MiB;
constexpr size_t WS_AB = WS_ACT, WS_GV = WS_ACT + 32 * MiB, WS_BT = WS_ACT + 48 * MiB;
constexpr size_t WS_QB = WS_ACT, WS_KB = WS_ACT + 32 * MiB, WS_VB = WS_ACT + 40 * MiB;
constexpr size_t WS_OB = WS_ACT + 88 * MiB;
constexpr size_t WS_END = WS_OB + 32 * MiB;
static_assert(WS_XB == 78 * MiB && WS_END <= 256 * MiB && WS_BT + 32 * MiB <= WS_END, "d_ws map");
constexpr int CW_TMO = 0, CW_BAR = 4096;
constexpr int RING_BYTES = 131072, LDSCTL_OFF = RING_BYTES, MISC_OFF = LDSCTL_OFF + 320, INTAB_OFF = LDSCTL_OFF + 1024, LDS_BYTES = 147456;

#define GAS __attribute__((address_space(1)))
#define LAS __attribute__((address_space(3)))
typedef unsigned short bf16;
typedef unsigned v4u __attribute__((ext_vector_type(4)));
typedef float f32x4 __attribute__((ext_vector_type(4)));
typedef short bf16x8 __attribute__((ext_vector_type(8)));
typedef float f32x16 __attribute__((ext_vector_type(16)));
typedef GAS unsigned gu32;
#define RLX_AGENT __ATOMIC_RELAXED, __HIP_MEMORY_SCOPE_AGENT
#define LDS_WAIT() asm volatile("s_waitcnt lgkmcnt(0)" ::: "memory")
#define VM_WAIT() asm volatile("s_waitcnt vmcnt(0)" ::: "memory")
__device__ __forceinline__ unsigned f2bf(float f) { unsigned u = __builtin_bit_cast(unsigned, f); return (u + 0x7fffu + ((u >> 16) & 1u)) >> 16; }
__device__ __forceinline__ unsigned pk2(float lo, float hi) { return f2bf(lo) | (f2bf(hi) << 16); }
__device__ __forceinline__ float bf2f(unsigned h) { return __uint_as_float(h << 16); }

#define XB_TMO      128
#define XB_XCNT(j)  (256  + 64 * (j))
#define XB_XSUB(j)  (1280 + 64 * (j))
#define XB_XGEN(j)  (2304 + 64 * (j))
#define XB_TOP      3328
#define XB_TOPGEN   3392
#define XCD_BAR_WORDS 3456
#define XB_SPIN_CAP (1u << 18)

__device__ __forceinline__ unsigned xb_ld(unsigned* p)              { return __hip_atomic_load(p, __ATOMIC_RELAXED, __HIP_MEMORY_SCOPE_AGENT); }
__device__ __forceinline__ unsigned xb_add(unsigned* p, unsigned v) { return __hip_atomic_fetch_add(p, v, __ATOMIC_RELAXED, __HIP_MEMORY_SCOPE_AGENT); }
__device__ __forceinline__ unsigned xb_xcc_id() { return (unsigned)__builtin_amdgcn_s_getreg((3 << 11) | 20) & 0xFu; }
#define XB_SPIN(cond, bar) do { unsigned _sp = 0; while (cond) { __builtin_amdgcn_s_sleep(1); \
    if ((++_sp & 255u) == 0u) { if (xb_ld(&(bar)[XB_TMO])) break; if (_sp > XB_SPIN_CAP) { atomicAdd(&(bar)[XB_TMO], 1u); break; } } } } while (0)

struct XcdBarrier {
    unsigned* bar; unsigned x;
    volatile LAS unsigned* st;
};

__device__ __forceinline__ XcdBarrier xcd_barrier_post(unsigned* bar, volatile LAS unsigned* st) {
    XcdBarrier b; b.bar = bar; b.x = xb_xcc_id(); b.st = st;
    if (threadIdx.x == 0) (void)xb_add(&bar[XB_XCNT(b.x)], 1u);
    return b;
}
__device__ __forceinline__ void xcd_barrier_complete(unsigned* bar, unsigned x, unsigned& nloc, unsigned& nx) {
    const unsigned G = gridDim.x * gridDim.y * gridDim.z;
    unsigned sum, cnt, mine, sp = 0u;
    for (;;) {
        sum = 0u; cnt = 0u; mine = 0u;
#pragma unroll 1
        for (unsigned j = 0; j < 16; ++j) { const unsigned c = xb_ld(&bar[XB_XCNT(j)]); sum += c; cnt += (c > 0u) ? 1u : 0u; }
        if (sum == G) { mine = xb_ld(&bar[XB_XCNT(x)]); break; }
        __builtin_amdgcn_s_sleep(1);
        if ((++sp & 255u) == 0u) { if (xb_ld(&bar[XB_TMO])) break; if (sp > XB_SPIN_CAP) { atomicAdd(&bar[XB_TMO], 1u); break; } }
    }
    nloc = mine > 0u ? mine : 1u; nx = cnt > 0u ? cnt : 1u;
}

__device__ __forceinline__ void xcd_barrier(const XcdBarrier& b) {
    asm volatile("s_waitcnt vmcnt(0)" ::: "memory");
    __syncthreads();
    if (threadIdx.x == 0) {
        unsigned* bar = b.bar;
        __builtin_amdgcn_s_waitcnt(0);
        unsigned nloc = b.st[0], nx = b.st[1];
        if (nloc == 0u) { xcd_barrier_complete(bar, b.x, nloc, nx); b.st[0] = nloc; b.st[1] = nx; }
        const unsigned old = xb_add(&bar[XB_XSUB(b.x)], 1u);
        const unsigned gen = old / nloc;
        if (old + 1u == (gen + 1u) * nloc) {
            __builtin_amdgcn_fence(__ATOMIC_RELEASE, "agent");
            asm volatile("s_waitcnt vmcnt(0)" ::: "memory");
            const unsigned og = xb_add(&bar[XB_TOP], 1u);
            const unsigned tg = og / nx;
            if (og + 1u == (tg + 1u) * nx) xb_add(&bar[XB_TOPGEN], 1u);
            else XB_SPIN(xb_ld(&bar[XB_TOPGEN]) == tg, bar);
            __builtin_amdgcn_fence(__ATOMIC_ACQUIRE, "agent");
            xb_add(&bar[XB_XGEN(b.x)], 1u);
            asm volatile("s_waitcnt vmcnt(0)" ::: "memory");
        } else {
            XB_SPIN(xb_ld(&bar[XB_XGEN(b.x)]) == gen, bar);
            __builtin_amdgcn_fence(__ATOMIC_ACQUIRE, "agent");
            asm volatile("s_waitcnt vmcnt(0)" ::: "memory");
        }
    }
    __syncthreads();
}


struct Args { const float* in[20]; float* out; unsigned char* ws; const float* xsrc; int ph_lo, ph_hi, li, ss_idx; };
struct Frame {
    LAS unsigned char* lds; int tid, lane, wave, vcu, G;
    float* out; unsigned char* ws;
};
__device__ __forceinline__ const float* inp(const Frame& F, int i) {
    const unsigned long long v = *(const LAS unsigned long long*)(F.lds + INTAB_OFF + 8 * i);
    const unsigned lo = __builtin_amdgcn_readfirstlane((unsigned)v), hi = __builtin_amdgcn_readfirstlane((unsigned)(v >> 32));
    return (const float*)(((unsigned long long)hi << 32) | lo);
}
#ifndef MK_PHASES
#define MK_PHASES 0x3ffff
#endif
__device__ __forceinline__ float wave_sum(float v, int lane) {
#pragma unroll
    for (int o = 1; o < 64; o <<= 1) v += pg8::shx(v, lane, o);
    return v;
}
template <class Src>
__device__ __forceinline__ void p0_titem(Src src, bf16* dst, int dld, LAS float* scr, int lane) {
#pragma unroll 8
    for (int i = 0; i < 32; ++i) { const int kk = 2 * i + (lane >> 5); scr[kk * 33 + (lane & 31)] = src(kk, lane & 31); }
    LDS_WAIT(); asm volatile("" ::: "memory");
    const int c = lane & 7;
#pragma unroll
    for (int j = 0; j < 4; ++j) { const int n = (lane >> 3) + 8 * j; const LAS float* s = scr + (8 * c) * 33 + n;
        v4u o; o.x = pk2(s[0 * 33], s[1 * 33]); o.y = pk2(s[2 * 33], s[3 * 33]); o.z = pk2(s[4 * 33], s[5 * 33]); o.w = pk2(s[6 * 33], s[7 * 33]);
        *(GAS v4u*)(dst + (size_t)n * dld + 8 * c) = o; }
    LDS_WAIT(); asm volatile("" ::: "memory");
}
__device__ __forceinline__ void p0_plain(const float* W, int ldw, int N, const float* gain, bf16* dst, int dld, int gu_half  , LAS float* scr, int item, int lane) {
    const int nblk = N / 32, kb = item / nblk, nb = item % nblk, k0 = 64 * kb, n0 = 32 * nb;
    const int drow0 = gu_half < 0 ? n0 : 256 * (n0 >> 7) + 128 * gu_half + (n0 & 127);
    const int lr = lane >> 3, lc = (lane & 7) * 4;
    const float* Wp = W + (size_t)(k0 + lr) * ldw + n0 + lc;
    f32x4 v[8];
#pragma unroll
    for (int i = 0; i < 8; ++i) v[i] = *(const GAS f32x4*)(Wp + (size_t)(8 * i) * ldw);
    if (gain) {
#pragma unroll
        for (int i = 0; i < 8; ++i) v[i] = v[i] * gain[k0 + 8 * i + lr]; }
#pragma unroll
    for (int i = 0; i < 8; ++i) { LAS float* sp = scr + (8 * i + lr) * 33 + lc; sp[0] = v[i].x; sp[1] = v[i].y; sp[2] = v[i].z; sp[3] = v[i].w; }
    LDS_WAIT(); asm volatile("" ::: "memory");
    bf16* d = dst + (size_t)drow0 * dld + k0; const int c = lane & 7;
#pragma unroll
    for (int j = 0; j < 4; ++j) { const int n = (lane >> 3) + 8 * j; const LAS float* sq = scr + (8 * c) * 33 + n;
        v4u o; o.x = pk2(sq[0 * 33], sq[1 * 33]); o.y = pk2(sq[2 * 33], sq[3 * 33]); o.z = pk2(sq[4 * 33], sq[5 * 33]); o.w = pk2(sq[6 * 33], sq[7 * 33]);
        *(GAS v4u*)(d + (size_t)n * dld + 8 * c) = o; }
    LDS_WAIT(); asm volatile("" ::: "memory");
}
__device__ __forceinline__ void p0_prologue(Frame& F) {
    LAS float* scr = (LAS float*)(F.lds + F.wave * 16384);
    const int gw = F.vcu * NWAVES + F.wave, NGW = F.G * NWAVES, lane = F.lane;
    unsigned char* ws = F.ws;
    LAS float* ctab = scr + 64 * 33 + 16;
    { float s, c; sincospif((float)lane / 64.f, &s, &c); ctab[lane] = c; sincospif((float)(lane + 64) / 64.f, &s, &c); ctab[lane + 64] = c; }
    LDS_WAIT();
    constexpr int I_G = 16 * 88, I_D = 44 * 32, I_F = 3 * I_G;
    constexpr int I_INUV = 16 * 32, I_OUTG = 8 * 32, I_OUTF = 8 * 32, I_QKV = 16 * 48, I_O = 16 * 32, I_FOLD = 128 * 4 * 2;
    constexpr int NITEMS = 4 * I_F + I_INUV + I_OUTG + I_OUTF + I_QKV + I_O + I_FOLD;
    for (int it = gw; it < NITEMS; it += NGW) {
        int r = it;
        if (r < 4 * I_F) { const int f = r / I_F; r -= f * I_F; const int L = f >> 1, second = f & 1;
            const float* gn = inp(F, second ? 15 : 1) + L * D; const float* wg = inp(F, second ? 16 : 2) + (size_t)L * D * FF; const float* wu = inp(F, second ? 17 : 3) + (size_t)L * D * FF; const float* wd = inp(F, second ? 18 : 4) + (size_t)L * D * FF;
            bf16* wgu = (bf16*)(ws + WS_WGU) + (size_t)f * NGU * D; bf16* wdt = (bf16*)(ws + WS_WD) + (size_t)f * D * FF;
            if (r < I_G) { p0_plain(wg, FF, FF, gn, wgu, D, 0, scr, r, lane); continue; } r -= I_G;
            if (r < I_G) { p0_plain(wu, FF, FF, gn, wgu, D, 1, scr, r, lane); continue; } r -= I_G;
            p0_plain(wd, D, D, nullptr, wdt, FF, -1, scr, r, lane); continue; }
        r -= 4 * I_F;
        if (r < I_INUV) { p0_plain(inp(F, 6) + 512, NIN, 1024, inp(F, 5), (bf16*)(ws + WS_WIN) + (size_t)512 * D, D, -1, scr, r, lane); continue; } r -= I_INUV;
        if (r < I_OUTG) { p0_plain(inp(F, 10) + (size_t)512 * D, D, D, nullptr, (bf16*)(ws + WS_WOUT) + 512, D, -1, scr, r, lane); continue; } r -= I_OUTG;
        if (r < I_OUTF) {
            const int nblk = D / 32, kb = r / nblk, nb = r % nblk, k0 = 64 * kb, n0 = 32 * nb; const float* wo = inp(F, 10); const float sc = 6.9053396600248786e-4f;
            p0_titem([=](int kk, int nn) { const int kp = k0 + kk, g = kp >> 7, c = kp & 127; const float* w = wo + (size_t)(g * 128) * D + n0 + nn;
                    float v; if (c == 0) v = w[0]; else if (c == 64) v = w[(size_t)64 * D]; else if (c < 64) v = w[(size_t)c * D] + w[(size_t)(128 - c) * D]; else { const int j = c - 64; v = w[(size_t)(128 - j) * D] - w[(size_t)j * D]; }
                    return v * sc; }, (bf16*)(ws + WS_WOUT) + (size_t)n0 * D + k0, D, scr, lane);
            continue; }
        r -= I_OUTF;
        if (r < I_QKV) { p0_plain(inp(F, 11), NQKV, NQKV, inp(F, 5) + D, (bf16*)(ws + WS_WQKV), D, -1, scr, r, lane); continue; } r -= I_QKV;
        if (r < I_O) { p0_plain(inp(F, 14), D, D, nullptr, (bf16*)(ws + WS_WO), D, -1, scr, r, lane); continue; } r -= I_O;
        {
            const int kb = r >> 3, g = (r >> 1) & 3, ch = r & 1, k0 = 8 * kb, c = 64 * ch + lane;
            const int f = c <= 64 ? c : c - 64, ph = c <= 64 ? 0 : 32;
            const float* wi = inp(F, 6) + (size_t)k0 * NIN + g * 128;
            LAS float* wt = scr;
#pragma unroll
            for (int i = 0; i < 4; ++i) { const f32x4 w4 = *(const GAS f32x4*)(wi + (size_t)(2 * i + (lane >> 5)) * NIN + (lane & 31) * 4); *(LAS f32x4*)(wt + (2 * i + (lane >> 5)) * 128 + (lane & 31) * 4) = w4; }
            LDS_WAIT(); asm volatile("" ::: "memory");
            float a[8] = {0.f, 0.f, 0.f, 0.f, 0.f, 0.f, 0.f, 0.f};
            for (int d = 0; d < 128; ++d) { const float dm = ctab[(d * f - ph) & 127];
#pragma unroll
                for (int j = 0; j < 8; ++j) a[j] = fmaf(wt[j * 128 + d], dm, a[j]); }
            const float* gn = inp(F, 5) + k0;
            v4u o; o.x = pk2(a[0] * gn[0], a[1] * gn[1]); o.y = pk2(a[2] * gn[2], a[3] * gn[3]); o.z = pk2(a[4] * gn[4], a[5] * gn[5]); o.w = pk2(a[6] * gn[6], a[7] * gn[7]);
            *(GAS v4u*)((bf16*)(ws + WS_WIN) + (size_t)(g * 128 + c) * D + k0) = o;
            LDS_WAIT(); asm volatile("" ::: "memory"); }
    }
    const int gt = gw * 64 + lane, NGT = NGW * 64;
    for (int i = gt; i < 320 * 32; i += NGT) { const int p = i >> 5, j = i & 31; const float pos = (float)(p < 256 ? p : p - 256); const float inv = __builtin_amdgcn_exp2f(-(float)j * (13.287712379549449f / 32.f)); const float ang = pos * inv;
        float2 cs; sincospif(ang * 0.31830988618379067f, &cs.y, &cs.x); ((float2*)(ws + TAB_ROPE))[i] = cs; }
    for (int i = gt; i < 128 * 128; i += NGT) { const int n2 = i >> 7, k1 = i & 127; float s, c; sincospif((float)(n2 * k1) / 8192.f, &s, &c); float2 cs; cs.x = c; cs.y = s; ((float2*)(ws + TAB_TW))[i] = cs; }
    for (int i = gt; i < 256 * 128; i += NGT) { const int row = i >> 7, n1 = i & 127, k1 = row >> 1; float s, c; sincospif((float)((n1 * k1) & 127) / 64.f, &s, &c);
        ((bf16*)(ws + TAB_P1))[i] = (bf16)f2bf((row & 1) ? -s : c); }
    for (int i = gt; i < 256 * 256; i += NGT) { const int row = i >> 8, kk = i & 255, k2 = row >> 1, n2 = kk & 127; float s, c; sincospif((float)((n2 * k2) & 127) / 64.f, &s, &c);
        const float v = (row & 1) ? (kk < 128 ? s : -c) : (kk < 128 ? c : s); ((bf16*)(ws + TAB_P2))[i] = (bf16)f2bf(v); }
    for (int i = gt; i < 4 * 128 * 128; i += NGT) ((bf16*)(ws + TAB_WS))[i] = (bf16)f2bf(inp(F, 8)[i]);
}
__device__ __forceinline__ void refresh_rows(Frame& F, const float* X, float* ss) {
    const int gw = F.vcu * NWAVES + F.wave, NGW = F.G * NWAVES;
    for (int m = gw; m < M; m += NGW) { const GAS f32x4* xr = (const GAS f32x4*)(X + (size_t)m * D) + F.lane; f32x4 v[4]; float s = 0.f;
#pragma unroll
        for (int j = 0; j < 4; ++j) { v[j] = xr[64 * j]; s += (v[j].x * v[j].x + v[j].y * v[j].y) + (v[j].z * v[j].z + v[j].w * v[j].w); }
        s = wave_sum(s, F.lane); if (F.lane == 0) ss[m] = s;
        GAS unsigned long long* o8 = (GAS unsigned long long*)((bf16*)(F.ws + WS_XB) + (size_t)m * D) + F.lane;
#pragma unroll
        for (int j = 0; j < 4; ++j) o8[64 * j] = (unsigned long long)pk2(v[j].x, v[j].y) | ((unsigned long long)pk2(v[j].z, v[j].w) << 32); }
}
__device__ __forceinline__ void final_rows(Frame& F, const float* ss, const float* g) {
    const int gw = F.vcu * NWAVES + F.wave, NGW = F.G * NWAVES;
    for (int m = gw; m < M; m += NGW) { GAS f32x4* xr = (GAS f32x4*)(F.out + (size_t)m * D) + F.lane; const float r = __builtin_amdgcn_rsqf(ss[m] * (1.f / D) + 1e-6f);
#pragma unroll
        for (int j = 0; j < 4; ++j) { const f32x4 gv = ((const GAS f32x4*)g)[64 * j + F.lane]; xr[64 * j] = xr[64 * j] * r * gv; } }
}
__device__ __forceinline__ void rope_rows(Frame& F) {
    const int gw = F.vcu * NWAVES + F.wave, NGW = F.G * NWAVES, lane = F.lane;
    const float2* rt = (const float2*)(F.ws + TAB_ROPE);
    for (int it = gw; it < M * 10; it += NGW) { const int t = it / 10, h = it - t * 10;
        unsigned* p = h < 8 ? (unsigned*)((bf16*)(F.ws + WS_QB) + (size_t)t * 1024 + h * 128) + lane : (unsigned*)((bf16*)(F.ws + WS_KB) + (size_t)t * 256 + (h - 8) * 128) + lane;
        const float* g = h < 8 ? inp(F, 12) : inp(F, 13);
        const unsigned w = *p; float x0 = bf2f(w & 0xffffu), x1 = bf2f(w >> 16);
        const float rs = __builtin_amdgcn_rsqf(wave_sum(x0 * x0 + x1 * x1, lane) * (1.f / 128.f) + 1e-6f);
        x0 = x0 * rs * g[2 * lane]; x1 = x1 * rs * g[2 * lane + 1];
        const float2 cs = lane < 32 ? rt[(t >> 6) * 32 + lane] : rt[(256 + (t & 63)) * 32 + lane - 32];
        const float osc = h < 8 ? att::SCALE * 1.4426950408889634f : 1.f;
        *p = pk2((x0 * cs.x - x1 * cs.y) * osc, (x0 * cs.y + x1 * cs.x) * osc); }
}
__device__ __forceinline__ void pv_stage(const bf16* src, size_t rstride, int nrows, char* lds, int tid) {
    const int sr = tid >> 4, sc = (tid & 15) * 8;
#pragma unroll 4
    for (int r = sr; r < nrows; r += 32) { const bf16x8 v = *(const bf16x8*)(src + (size_t)r * rstride + sc);
        *(bf16x8*)(lds + (r >> 6) * 16384 + att::v_st(r & 63, sc)) = v; }
}
__device__ __forceinline__ void fourier1_phase(Frame& F) {
    char* lds = (char*)F.lds; const int tid = F.tid, w = F.wave, lane = F.lane, r32 = lane & 31, hi = lane >> 5;
    const bf16* P1 = (const bf16*)(F.ws + TAB_P1); const bf16* AB = (const bf16*)(F.ws + WS_AB); bf16* BT = (bf16*)(F.ws + WS_BT); const float2* TW = (const float2*)(F.ws + TAB_TW);
    bf16x8 pa[8];
#pragma unroll
    for (int ks = 0; ks < 8; ++ks) pa[ks] = *(const bf16x8*)(P1 + (size_t)(32 * w + r32) * 128 + 16 * ks + 8 * hi);
    const int vb = (int)(uintptr_t)lds + att::v_rd_base(lane);
    for (int it = F.vcu; it < 512; it += F.G) { const int n2 = it >> 2, cb = it & 3;
        __syncthreads();
        pv_stage(AB + (size_t)n2 * 1024 + cb * 128, (size_t)128 * 1024, 128, lds, tid);
        __syncthreads();
        f32x16 o[4] = {};
        att::pv_d0(o, vb, pa[0], pa[1], pa[2], pa[3]); att::pv_d0(o, vb + 16384, pa[4], pa[5], pa[6], pa[7]);
#pragma unroll
        for (int t = 0; t < 8; ++t) { const int k1 = (32 * w + att::crow(2 * t, hi)) >> 1; const float2 cs = TW[n2 * 128 + k1];
            bf16* dr = BT + ((size_t)(k1 * 2) * 128 + n2) * 512 + cb * 128 + r32; bf16* di = dr + (size_t)128 * 512;
#pragma unroll
            for (int d0 = 0; d0 < 4; ++d0) { const float re = o[d0][2 * t], im = o[d0][2 * t + 1];
                dr[d0 * 32] = (bf16)f2bf(re * cs.x + im * cs.y); di[d0 * 32] = (bf16)f2bf(im * cs.x - re * cs.y); } }
    }
}
__device__ __forceinline__ void fourier2_phase(Frame& F) {
    char* lds = (char*)F.lds; const int tid = F.tid, w = F.wave, lane = F.lane, r32 = lane & 31, hi = lane >> 5;
    const bf16* P2 = (const bf16*)(F.ws + TAB_P2); bf16* AB = (bf16*)(F.ws + WS_AB); const bf16* BT = (const bf16*)(F.ws + WS_BT);
    bf16x8 pa[16];
#pragma unroll
    for (int ks = 0; ks < 16; ++ks) pa[ks] = *(const bf16x8*)(P2 + (size_t)(32 * w + r32) * 256 + 16 * ks + 8 * hi);
    const int vb = (int)(uintptr_t)lds + att::v_rd_base(lane);
    for (int it = F.vcu; it < 512; it += F.G) { const int k1 = it >> 2, cb = it & 3;
        __syncthreads();
        pv_stage(BT + (size_t)k1 * 256 * 512 + cb * 128, 512, 256, lds, tid);
        __syncthreads();
        f32x16 o[4] = {};
        att::pv_d0(o, vb, pa[0], pa[1], pa[2], pa[3]); att::pv_d0(o, vb + 16384, pa[4], pa[5], pa[6], pa[7]);
        att::pv_d0(o, vb + 32768, pa[8], pa[9], pa[10], pa[11]); att::pv_d0(o, vb + 49152, pa[12], pa[13], pa[14], pa[15]);
#pragma unroll
        for (int t = 0; t < 8; ++t) { const int k2 = (32 * w + att::crow(2 * t, hi)) >> 1; bf16* dst = AB + (size_t)(k1 + 128 * k2) * 1024 + cb * 128 + r32;
#pragma unroll
            for (int d0 = 0; d0 < 4; ++d0) { const int c = 32 * d0 + r32; dst[d0 * 32] = (bf16)f2bf(c <= 64 ? o[d0][2 * t] : o[d0][2 * t + 1]); } }
    }
}
__device__ __forceinline__ void gate_phase(Frame& F) {
    char* lds = (char*)F.lds; const int tid = F.tid, w = F.wave, lane = F.lane, r32 = lane & 31, hi = lane >> 5;
    const bf16* WS = (const bf16*)(F.ws + TAB_WS); bf16* AB = (bf16*)(F.ws + WS_AB); const bf16* GV = (const bf16*)(F.ws + WS_GV);
    const int vb = (int)(uintptr_t)lds + att::v_rd_base(lane); const int rb = w & 3, ch = w >> 2;
    const int sr = tid >> 4, sc = (tid & 15) * 8;
    for (int it = F.vcu; it < 512; it += F.G) { const int c = it >> 2, g = it & 3;
        __syncthreads();
        {
            const float* vn = inp(F, 7) + g * 128 + sc; float gn[8];
#pragma unroll
            for (int j = 0; j < 8; ++j) gn[j] = vn[j];
#pragma unroll
            for (int p = 0; p < 4; ++p) { const int r = sr + 32 * p; const bf16x8 v = *(const bf16x8*)(GV + (size_t)(128 * c + r) * 512 + g * 128 + sc); float x[8]; float s = 0.f;
#pragma unroll
                for (int j = 0; j < 8; ++j) { x[j] = bf2f((unsigned short)v[j]); s += x[j] * x[j]; }
                s += pg8::shx(s, lane, 1); s += pg8::shx(s, lane, 2); s += pg8::shx(s, lane, 4); s += pg8::shx(s, lane, 8);
                const float rs = __builtin_amdgcn_rsqf(s * (1.f / 128.f) + 1e-6f);
                v4u o; o.x = pk2(x[0] * rs * gn[0], x[1] * rs * gn[1]); o.y = pk2(x[2] * rs * gn[2], x[3] * rs * gn[3]); o.z = pk2(x[4] * rs * gn[4], x[5] * rs * gn[5]); o.w = pk2(x[6] * rs * gn[6], x[7] * rs * gn[7]);
                *(v4u*)(lds + (r >> 6) * 16384 + att::v_st(r & 63, sc)) = o; } }
        bf16x8 pa[8];
#pragma unroll
        for (int ks = 0; ks < 8; ++ks) pa[ks] = *(const bf16x8*)(WS + (size_t)(g * 128 + 32 * rb + r32) * 128 + 16 * ks + 8 * hi);
        __syncthreads();
        f32x16 o[2] = {};
        if (ch == 0) { att::pv_one<0>(o[0], vb, pa[0], pa[1], pa[2], pa[3]); att::pv_one<1>(o[1], vb, pa[0], pa[1], pa[2], pa[3]);
                       att::pv_one<0>(o[0], vb + 16384, pa[4], pa[5], pa[6], pa[7]); att::pv_one<1>(o[1], vb + 16384, pa[4], pa[5], pa[6], pa[7]); }
        else         { att::pv_one<2>(o[0], vb, pa[0], pa[1], pa[2], pa[3]); att::pv_one<3>(o[1], vb, pa[0], pa[1], pa[2], pa[3]);
                       att::pv_one<2>(o[0], vb + 16384, pa[4], pa[5], pa[6], pa[7]); att::pv_one<3>(o[1], vb + 16384, pa[4], pa[5], pa[6], pa[7]); }
        const float* bs = inp(F, 9) + g * 128;
#pragma unroll
        for (int r = 0; r < 16; ++r) { const int p = 32 * rb + att::crow(r, hi); const float b = bs[p]; bf16* up = AB + (size_t)(128 * c + p) * 1024 + 512 + g * 128 + 64 * ch + r32;
#pragma unroll
            for (int dd = 0; dd < 2; ++dd) { const float u = bf2f(up[dd * 32]); up[dd * 32] = (bf16)f2bf(u * (o[dd][r] + b)); } }
    }
}
constexpr int N_PHASES = 18;
__device__ __forceinline__ float* rowss_ptr(unsigned char* ws, int k) { return (float*)(ws + WS_ROWSS) + (size_t)k * M; }

__device__ __forceinline__ int launder_s(int v) { v = __builtin_amdgcn_readfirstlane(v); asm volatile("" : "+s"(v)); return v; }
template <class T> __device__ __forceinline__ T* launder_p(T* p) { const unsigned long long u = (unsigned long long)p; const unsigned lo = (unsigned)launder_s((int)(unsigned)u), hi = (unsigned)launder_s((int)(unsigned)(u >> 32)); return (T*)(((unsigned long long)hi << 32) | lo); }
__global__ void __launch_bounds__(NWAVES * 64, 2) mk_fwd(Args args) {
    extern __shared__ __attribute__((aligned(16))) unsigned char lds[];
    Frame F;
    F.lds = (LAS unsigned char*)lds;
    F.tid = threadIdx.x; F.lane = F.tid & 63; F.wave = __builtin_amdgcn_readfirstlane(F.tid >> 6);
    F.G = gridDim.x; { const int bx = blockIdx.x; F.vcu = (F.G % 8 == 0) ? (bx % 8) * (F.G / 8) + bx / 8 : bx; }
    F.out = args.out; F.ws = args.ws;
    int bx = blockIdx.x;
    volatile LAS unsigned* MISC = (volatile LAS unsigned*)(F.lds + MISC_OFF);
    for (int u = F.tid; u < (LDS_BYTES - LDSCTL_OFF) / 4; u += NWAVES * 64) ((LAS unsigned*)(F.lds + LDSCTL_OFF))[u] = 0u;
    __syncthreads();
    if (F.tid < 20) *(LAS unsigned long long*)(F.lds + INTAB_OFF + 8 * F.tid) = (unsigned long long)args.in[F.tid];
    if (F.tid == 20) *(LAS unsigned long long*)(F.lds + INTAB_OFF + 8 * 20) = (unsigned long long)args.xsrc;
    __syncthreads();
    const int lo = args.ph_lo, hi = args.ph_hi;
    XcdBarrier bar; bar.bar = (unsigned*)(args.ws + WS_CTL) + CW_BAR + args.li * XCD_BAR_WORDS; bar.x = 0; bar.st = nullptr;
    if (hi - lo > 1) bar = xcd_barrier_post((unsigned*)(args.ws + WS_CTL) + CW_BAR + args.li * XCD_BAR_WORDS, MISC + 8);

#ifndef MK_REP_PH
#define MK_REP_PH -1
#define MK_REP_N 0
#endif
    for (int ph = lo; ph < hi; ++ph) {
      const int reps = (ph == MK_REP_PH) ? 1 + MK_REP_N : 1;
      for (int rep = 0; rep < reps; ++rep) {
        const int dry = rep + 1 < reps;
        asm volatile("v_mbcnt_lo_u32_b32 %0, -1, 0\n\tv_mbcnt_hi_u32_b32 %0, -1, %0" : "=&v"(F.lane)); F.tid = F.wave * 64 + F.lane; F.lds = (LAS unsigned char*)(uintptr_t)launder_s((int)(uintptr_t)F.lds);
        bar.bar = launder_p(bar.bar); bar.x = (unsigned)launder_s((int)bar.x);
        F.ws = launder_p(F.ws); F.out = launder_p(F.out); F.vcu = launder_s(F.vcu); F.G = launder_s(F.G); F.wave = launder_s(F.wave); bx = launder_s(bx);
        unsigned char* ws = F.ws;
        if (!((MK_PHASES >> ph) & 1)) {}
        else if (ph == 0) { p0_prologue(F); refresh_rows(F, inp(F, 20), rowss_ptr(ws, args.ss_idx)); }
        else if (ph == 1 || ph == 7 || ph == 9 || ph == 15) {
            const int f = ph == 1 ? 0 : (ph == 7 ? 1 : (ph == 9 ? 2 : 3)); const int ssi = ph == 1 ? 0 : (ph == 7 ? 2 : (ph == 9 ? 3 : 5));
            pg8::Gemm g{(const bf16*)(ws + WS_XB), (const bf16*)(ws + WS_WGU) + (size_t)f * NGU * D, M, NGU, D}; pg8::StaticOrder S; S.init(M, NGU, F.G, bx);
            pg8::EpiGU E{(bf16*)(ws + WS_ACT), FF, rowss_ptr(ws, ssi), 1.f / D};
            pg8::gemm_phase<pg8::EpiGU, pg8::StaticOrder, true, true>(F.lds, g, S, E, F.tid);
        }
        else if (ph == 2 || ph == 8 || ph == 10 || ph == 16 || ph == 6 || ph == 14) {
            const bool dn = !(ph == 6 || ph == 14); const int f = ph == 2 ? 0 : (ph == 8 ? 1 : (ph == 10 ? 2 : 3));
            const int sso = ph == 2 ? 1 : (ph == 6 ? 2 : (ph == 8 ? 3 : (ph == 10 ? 4 : (ph == 14 ? 5 : 6))));
            const bf16* A = dn ? (const bf16*)(ws + WS_ACT) : (ph == 6 ? (const bf16*)(ws + WS_AB) : (const bf16*)(ws + WS_OB));
            const bf16* Bt = dn ? (const bf16*)(ws + WS_WD) + (size_t)f * D * FF : (ph == 6 ? (const bf16*)(ws + WS_WOUT) : (const bf16*)(ws + WS_WO));
            pg8::Gemm g{A, Bt, M, D, dn ? FF : D}; pg8::StaticOrder S; S.init(M, D, F.G, bx);
            pg8::EpiRes E{(ph == 2 && args.ss_idx == 0) ? inp(F, 20) : F.out, F.out, (bf16*)(ws + WS_XB), rowss_ptr(ws, sso), dn ? 0.5f : 1.f, dry};
            pg8::gemm_phase<pg8::EpiRes, pg8::StaticOrder, false, true>(F.lds, g, S, E, F.tid);
        }
        else if (ph == 3 || ph == 11) {
            const bool l0 = ph == 3;
            pg8::Gemm g{(const bf16*)(ws + WS_XB), l0 ? (const bf16*)(ws + WS_WIN) : (const bf16*)(ws + WS_WQKV), M, 1536, D}; pg8::StaticOrder S; S.init(M, 1536, F.G, bx);
            pg8::EpiRoute E{(bf16*)(ws + WS_ACT), l0 ? (bf16*)(ws + WS_GV) : (bf16*)(ws + WS_KB), l0 ? (size_t)256 : (size_t)(WS_VB - WS_KB) / 2, l0 ? 512 : 256, l0 ? 2 : 99, rowss_ptr(ws, l0 ? 1 : 4), 1.f / D};
            pg8::gemm_phase<pg8::EpiRoute, pg8::StaticOrder, true, true>(F.lds, g, S, E, F.tid);
        }
        else if (ph == 4) { fourier1_phase(F); if (!dry) gate_phase(F); }
        else if (ph == 5) { fourier2_phase(F); }
        else if (ph == 12) { if (!dry) rope_rows(F); }
        else if (ph == 13) {
            const int h = F.vcu >> 5, kvh = h >> 2; const int seq = launder_s(M);
            float m0l; { const float* gq = inp(F, 12); const float* gk = inp(F, 13); float mq = fmaxf(fabsf(gq[F.lane]), fabsf(gq[F.lane + 64])), mk = fmaxf(fabsf(gk[F.lane]), fabsf(gk[F.lane + 64]));
#pragma unroll
                for (int o = 1; o < 64; o <<= 1) { mq = fmaxf(mq, pg8::shx(mq, F.lane, o)); mk = fmaxf(mk, pg8::shx(mk, F.lane, o)); }
                m0l = (11.313708499f * 1.4426950408889634f) * mq * mk; }
            const bool fast = __builtin_amdgcn_readfirstlane((int)(m0l <= 64.f)) != 0;
#pragma unroll 1
            for (int i = 0; i < 2; ++i) { const int qb = 2 * (F.vcu & 31) + i;
                att::bf16* Q = (att::bf16*)(ws + WS_QB) + (size_t)qb * 256 * 1024 + h * 128; att::bf16* O = (att::bf16*)(ws + WS_OB) + (size_t)qb * 256 * 1024 + h * 128;
                const att::bf16* Kp = (const att::bf16*)(ws + WS_KB) + kvh * 128; const att::bf16* Vp = (const att::bf16*)(ws + WS_VB) + kvh * 128;

#ifdef MK_ABL
                if (dry) { att::attn_stag_body<false, MK_ABL>(Q, Kp, Vp, O, seq, (char*)lds, F.tid); continue; }
#endif
                if (fast) att::attn_stag_body<false>(Q, Kp, Vp, O, seq, (char*)lds, F.tid); else att::attn_stag_body<true>(Q, Kp, Vp, O, seq, (char*)lds, F.tid); }
        }
        else if (ph == 17) { if (!dry) final_rows(F, rowss_ptr(ws, 6), inp(F, 19)); }
        if (ph + 1 < hi || dry) xcd_barrier(bar);
      }
    }
}

#ifndef MK_MODE
#define MK_MODE 0
#endif
#ifndef MK_OPT_MASK
#define MK_OPT_MASK 0x7f
#endif
static int mk_grid() {
    static int grid = 0;
    if (grid == 0) {
        int dev = 0, cus = 0, per_cu = 0;
        if (hipGetDevice(&dev) != hipSuccess || hipDeviceGetAttribute(&cus, hipDeviceAttributeMultiprocessorCount, dev) != hipSuccess) { fprintf(stderr, "kernel_launch: device query failed\n"); grid = -1; return grid; }
        if (hipFuncSetAttribute((const void*)mk_fwd, hipFuncAttributeMaxDynamicSharedMemorySize, LDS_BYTES) != hipSuccess) { fprintf(stderr, "kernel_launch: hipFuncSetAttribute failed\n"); grid = -1; return grid; }
        if (hipOccupancyMaxActiveBlocksPerMultiprocessor(&per_cu, (const void*)mk_fwd, NWAVES * 64, LDS_BYTES) != hipSuccess || per_cu < 1) { fprintf(stderr, "kernel_launch: occupancy query says %d blocks per CU\n", per_cu); (void)hipGetLastError(); per_cu = 1; }
        grid = cus;
        if (grid != 256) fprintf(stderr, "kernel_launch: %d CUs (built for 256)\n", grid);
    }
    return grid;
}
static void mk_launch(hipStream_t stream, Args a, int lo, int hi, int li, int grid) {
    a.ph_lo = lo; a.ph_hi = hi; a.li = li;
    if (hi - lo > 1) { void* params[] = {&a}; hipError_t e = hipLaunchCooperativeKernel((const void*)mk_fwd, dim3(grid), dim3(NWAVES * 64), params, LDS_BYTES, stream);
        if (e != hipSuccess) fprintf(stderr, "kernel_launch: cooperative launch failed: %s\n", hipGetErrorString(e)); }
    else { hipLaunchKernelGGL(mk_fwd, dim3(grid), dim3(NWAVES * 64), LDS_BYTES, stream, a);
        const hipError_t le = hipPeekAtLastError(); if (le != hipSuccess) fprintf(stderr, "kernel_launch: launch [%d,%d) failed: %s\n", lo, hi, hipGetErrorName(le)); }
}
extern "C" void kernel_launch(void* const* d_in, const int* in_sizes, int n_in, void* d_out, int out_size, void* d_ws, size_t ws_size, hipStream_t stream) {
    const int grid = mk_grid(); if (grid < 0) return;
    if (n_in != 20 || out_size != M * D || ws_size < WS_END) { fprintf(stderr, "kernel_launch: unexpected shapes (n_in %d out %d ws %zu)\n", n_in, out_size, ws_size); return; }
    Args a{};
    for (int i = 0; i < 20; ++i) a.in[i] = (const float*)d_in[i];
    a.out = (float*)d_out; a.ws = (unsigned char*)d_ws; a.xsrc = (const float*)d_in[0]; a.ss_idx = 0;
#if MK_MODE == 0
    (void)hipMemsetAsync((char*)d_ws + WS_CTL, 0, CTL_ZERO_BYTES, stream);
    mk_launch(stream, a, 0, N_PHASES, 0, grid);
#elif MK_MODE == 1
    (void)hipMemsetAsync((char*)d_ws + WS_CTL, 0, CTL_ZERO_BYTES, stream);
    for (int ph = 0; ph < N_PHASES; ++ph) mk_launch(stream, a, ph, ph + 1, 0, grid);
#else
    nv::setup();
    const float* const* in = (const float* const*)d_in; float* X = (float*)d_out; float* scr = (float*)d_ws; const size_t WFF = (size_t)D * FF;
    (void)hipMemcpyAsync(X, in[0], (size_t)M * D * 4, hipMemcpyDeviceToDevice, stream);
    const int sb_lo[7] = {1, 3, 7, 9, 11, 15, 17}, sb_hi[7] = {3, 7, 9, 11, 15, 17, 18};
    for (int sb = 0; sb < 7; ++sb) {
        if ((MK_OPT_MASK >> sb) & 1) {
            (void)hipMemsetAsync((char*)d_ws + WS_CTL, 0, CTL_ZERO_BYTES, stream);
            Args b = a; b.xsrc = X; b.ss_idx = sb; mk_launch(stream, b, 0, 1, 0, grid);
            for (int ph = sb_lo[sb]; ph < sb_hi[sb]; ++ph) mk_launch(stream, b, ph, ph + 1, 0, grid);
        } else switch (sb) {
            case 0: nv::ffn(stream, X, in[1], in[2], in[3], in[4], scr); break;
            case 1: nv::mix0(stream, X, in[5], in[6], in[7], in[8], in[9], in[10], scr); break;
            case 2: nv::ffn(stream, X, in[15], in[16], in[17], in[18], scr); break;
            case 3: nv::ffn(stream, X, in[1] + 1024, in[2] + WFF, in[3] + WFF, in[4] + WFF, scr); break;
            case 4: nv::mix1(stream, X, in[5] + 1024, in[11], in[12], in[13], in[14], scr); break;
            case 5: nv::ffn(stream, X, in[15] + 1024, in[16] + WFF, in[17] + WFF, in[18] + WFF, scr); break;
            case 6: nv::final_norm(stream, X, in[19]); break; }
    }
#endif
}
```
